# Optimizing an MI355X kernel written in HIP

```python
import math
import jax, jax.numpy as jnp
from jax import lax
import numpy as np

D_MODEL = 4096
BATCH = 16
SEQ = 256
DEPTH = 2
DEC_BATCH = 8
DEC_SEQ = 4096
PAST_LEN = 256

GRID_W = 64
HEAD_DIM = 128
ROPE_THETA = 10000.0
NORM_EPS = 1e-6
Q_BLOCK = 128

DN_HEADS = 8
DN_DK = 128
DN_DV = 128
DN_W = DN_HEADS * DN_DV
CONV_K = 3
DN_CHUNK = 64
GQA_Q_HEADS = 16
GQA_KV_HEADS = 4
GQA_W = GQA_Q_HEADS * HEAD_DIM
DIFF_HEADS = 4
DIFF_W = DIFF_HEADS * 2 * HEAD_DIM

MIX_W = DN_W + GQA_W + DIFF_W
IN_SPLITS = (DN_W, DN_W, DN_W, DN_W, 2 * DN_HEADS, 2 * DN_HEADS,
             GQA_W, GQA_KV_HEADS * HEAD_DIM, GQA_KV_HEADS * HEAD_DIM, GQA_W,
             DIFF_W, DIFF_W, DIFF_W, DIFF_W)
IN_COLS = 4 * DN_W + 4 * DN_HEADS + 2 * GQA_W + 2 * GQA_KV_HEADS * HEAD_DIM + 4 * DIFF_W

kernel_name = 'hybrid_deltanet_gqa_diffattn_prefix_dit'


def rms_norm(x, w):
    xf = x.astype(jnp.float32)
    y = xf * lax.rsqrt(jnp.mean(xf * xf, axis=-1, keepdims=True) + NORM_EPS)
    return (y * w.astype(jnp.float32)).astype(x.dtype)


def l2_norm(x):
    xf = x.astype(jnp.float32)
    return xf * lax.rsqrt(jnp.sum(xf * xf, axis=-1, keepdims=True) + NORM_EPS)


def modulation(cond, w_mod_l, b_mod_l):
    m = jax.nn.silu(cond) @ w_mod_l + b_mod_l
    return tuple(jnp.split(m, 3, axis=-1))


def split_projection(z):
    offs = np.cumsum(np.array(IN_SPLITS))[:-1].tolist()
    return jnp.split(z, offs, axis=-1)


def axial_rope_tables(t_len):
    n_rows = t_len // GRID_W
    row = jnp.repeat(jnp.arange(n_rows), GRID_W)
    col = jnp.tile(jnp.arange(GRID_W), n_rows)
    half = HEAD_DIM // 2
    inv_freq = ROPE_THETA ** (-jnp.arange(0, half, 2, dtype=jnp.float32) / half)
    pos = jnp.stack([row, col], axis=-1).astype(jnp.float32)
    ang = pos[..., None] * inv_freq
    ang = jnp.concatenate([ang, ang], axis=-1)
    return jnp.cos(ang), jnp.sin(ang)


def apply_rope(x, cos, sin):
    shp = x.shape
    xr = x.reshape(shp[:-1] + (2, HEAD_DIM // 2)).astype(jnp.float32)
    x1, x2 = jnp.split(xr, 2, axis=-1)
    rot = jnp.concatenate([-x2, x1], axis=-1)
    out = xr * cos[:, None] + rot * sin[:, None]
    return out.reshape(shp).astype(x.dtype)


def short_conv(x, w):
    t_len = x.shape[1]
    pad = CONV_K // 2
    xp = jnp.pad(x, ((0, 0), (pad, CONV_K - 1 - pad), (0, 0)))
    y = xp[:, 0:t_len] * w[0]
    for j in range(1, CONV_K):
        y = y + xp[:, j:j + t_len] * w[j]
    return jax.nn.silu(y)


def gated_delta_chunked(q, k, v, g, beta, s0):
    b, h, t_len, dk = q.shape
    dv = v.shape[-1]
    n = t_len // DN_CHUNK
    chunk = lambda t: t.reshape((b, h, n, DN_CHUNK) + t.shape[3:])
    q = chunk(q) * (dk ** -0.5)
    k, v, beta = chunk(k), chunk(v), chunk(beta)
    g = jnp.cumsum(chunk(g), axis=-1)
    idx = jnp.arange(DN_CHUNK)
    incl = idx[:, None] >= idx[None, :]
    strict = idx[:, None] > idx[None, :]
    decay = jnp.exp(jnp.where(incl, g[..., :, None] - g[..., None, :], -jnp.inf))
    kb = k * beta[..., None]
    l_mat = jnp.where(strict, jnp.einsum('bhnid,bhnjd->bhnij', kb, k) * decay, 0.0)
    eye = jnp.eye(DN_CHUNK, dtype=jnp.float32)
    rhs = jnp.concatenate([v * beta[..., None], kb * jnp.exp(g)[..., None]], axis=-1)
    uw = lax.linalg.triangular_solve(l_mat + eye, rhs, left_side=True, lower=True, unit_diagonal=True)
    u, w = uw[..., :dv], uw[..., dv:]
    qk = jnp.einsum('bhnid,bhnjd->bhnij', q, k) * decay
    g_last = g[..., -1]
    k_dec = k * jnp.exp(g_last[..., None] - g)[..., None]
    q_dec = q * jnp.exp(g)[..., None]
    xs = tuple(jnp.moveaxis(t, 2, 0) for t in (q_dec, k_dec, u, w, qk, g_last))

    def step(s, inp):
        qn, kn, un, wn, qkn, gl = inp
        v_new = un - jnp.einsum('bhck,bhkv->bhcv', wn, s)
        o = jnp.einsum('bhck,bhkv->bhcv', qn, s) + jnp.einsum('bhij,bhjv->bhiv', qkn, v_new)
        s = s * jnp.exp(gl)[..., None, None] + jnp.einsum('bhck,bhcv->bhkv', kn, v_new)
        return s, o

    s_final, o = lax.scan(step, s0, xs)
    o = jnp.moveaxis(o, 0, 2).reshape(b, h, t_len, dv)
    return o, s_final


def sweep_query_blocks(fn, q):
    b, t_len = q.shape[:2]
    nb = t_len // Q_BLOCK
    qb = jnp.moveaxis(q.reshape((b, nb, Q_BLOCK) + q.shape[2:]), 1, 0)
    out = lax.map(fn, qb)
    return jnp.moveaxis(out, 0, 1).reshape((b, t_len) + out.shape[3:])


def gqa_attend(q, k, v):
    b = q.shape[0]
    grp = GQA_Q_HEADS // GQA_KV_HEADS
    scale = HEAD_DIM ** -0.5

    def block(qb):
        qg = qb.reshape(b, Q_BLOCK, GQA_KV_HEADS, grp, HEAD_DIM)
        s = jnp.einsum('bqkgd,bskd->bkgqs', qg, k).astype(jnp.float32) * scale
        p = jax.nn.softmax(s, axis=-1)
        o = jnp.einsum('bkgqs,bskd->bqkgd', p.astype(v.dtype), v)
        return o.reshape(b, Q_BLOCK, GQA_W)

    return sweep_query_blocks(block, q)


def diff_attend(q, k, v, lam, norm_w, lambda_init):
    b = q.shape[0]
    scale = HEAD_DIM ** -0.5

    def block(qb):
        s = jnp.einsum('bqhid,bshid->bihqs', qb, k).astype(jnp.float32) * scale
        p = jax.nn.softmax(s, axis=-1)
        a = p[:, 0] - lam * p[:, 1]
        o = jnp.einsum('bhqs,bshe->bqhe', a.astype(v.dtype), v)
        o = rms_norm(o, norm_w) * (1.0 - lambda_init)
        return o.reshape(b, Q_BLOCK, DIFF_W)

    return sweep_query_blocks(block, q)


def mixer_layer(x, mod, weights, lambda_init, ctx):
    (pre_w, post_w, w_in, w_out, conv_w, a_log, dt_bias, dn_norm_w,
     q_norm_w, k_norm_w, diff_lam, diff_norm_w) = weights
    shift, scale, gate = mod
    b, t_len, _ = x.shape
    h = rms_norm(x, pre_w) * (1.0 + scale) + shift
    (dq, dk, dv, dgate, dalpha, dbeta, gq, gk, gv, ggate,
     fq, fk, fv, fgate) = split_projection(h @ w_in)

    dq, dk, dv = jnp.split(short_conv(jnp.concatenate([dq, dk, dv], axis=-1), conv_w), 3, axis=-1)
    dn_heads = lambda t: jnp.transpose(t.reshape(b, t_len, DN_HEADS, -1), (0, 2, 1, 3)).astype(jnp.float32)
    dq, dk, dv = l2_norm(dn_heads(dq)), l2_norm(dn_heads(dk)), dn_heads(dv)
    alpha = dalpha.reshape(b, t_len, 2, DN_HEADS).astype(jnp.float32)
    g = -jnp.exp(a_log.astype(jnp.float32)) * jax.nn.softplus(alpha + dt_bias.astype(jnp.float32))
    g = jnp.transpose(g, (0, 2, 3, 1))
    beta = jnp.transpose(jax.nn.sigmoid(dbeta.reshape(b, t_len, 2, DN_HEADS).astype(jnp.float32)), (0, 2, 3, 1))
    if ctx is None:
        s0 = jnp.zeros((b, 2, DN_HEADS, DN_DK, DN_DV), jnp.float32)
    else:
        s0 = ctx[4].astype(jnp.float32)
    flip = lambda t: jnp.flip(t, axis=2)
    o_f, s_f = gated_delta_chunked(dq, dk, dv, g[:, 0], beta[:, 0], s0[:, 0])
    o_b, s_b = gated_delta_chunked(flip(dq), flip(dk), flip(dv), flip(g[:, 1]), flip(beta[:, 1]), s0[:, 1])
    dn_o = jnp.transpose(o_f + flip(o_b), (0, 2, 1, 3))
    dn_out = rms_norm(dn_o, dn_norm_w).reshape(b, t_len, DN_W).astype(x.dtype) * jax.nn.silu(dgate)

    gq = rms_norm(gq.reshape(b, t_len, GQA_Q_HEADS, HEAD_DIM), q_norm_w)
    gk = rms_norm(gk.reshape(b, t_len, GQA_KV_HEADS, HEAD_DIM), k_norm_w)
    gv = gv.reshape(b, t_len, GQA_KV_HEADS, HEAD_DIM)
    fq = fq.reshape(b, t_len, DIFF_HEADS, 2, HEAD_DIM)
    fk = fk.reshape(b, t_len, DIFF_HEADS, 2, HEAD_DIM)
    fv = fv.reshape(b, t_len, DIFF_HEADS, 2 * HEAD_DIM)
    if ctx is None:
        gk_all, gv_all, fk_all, fv_all = gk, gv, fk, fv
        new_ctx = (gk, gv, fk, fv, jnp.stack([s_f, s_b], axis=1).astype(x.dtype))
    else:
        cos, sin = axial_rope_tables(t_len)
        gq = apply_rope(gq, cos, sin)
        fq = apply_rope(fq.reshape(b, t_len, 2 * DIFF_HEADS, HEAD_DIM), cos, sin).reshape(b, t_len, DIFF_HEADS, 2, HEAD_DIM)
        fk_lat = apply_rope(fk.reshape(b, t_len, 2 * DIFF_HEADS, HEAD_DIM), cos, sin).reshape(b, t_len, DIFF_HEADS, 2, HEAD_DIM)
        gk_all = jnp.concatenate([apply_rope(gk, cos, sin), ctx[0].astype(gk.dtype)], axis=1)
        gv_all = jnp.concatenate([gv, ctx[1].astype(gv.dtype)], axis=1)
        fk_all = jnp.concatenate([fk_lat, ctx[2].astype(fk.dtype)], axis=1)
        fv_all = jnp.concatenate([fv, ctx[3].astype(fv.dtype)], axis=1)
        new_ctx = None

    gqa_out = gqa_attend(gq, gk_all, gv_all) * jax.nn.silu(ggate)
    lam_p = diff_lam.astype(jnp.float32)
    lam = jnp.exp(jnp.sum(lam_p[0] * lam_p[1])) - jnp.exp(jnp.sum(lam_p[2] * lam_p[3])) + lambda_init
    diff_out = diff_attend(fq, fk_all, fv_all, lam, diff_norm_w, lambda_init) * jax.nn.silu(fgate)

    mix = jnp.concatenate([dn_out, gqa_out, diff_out], axis=-1) @ w_out
    return x + gate * rms_norm(mix, post_w), new_ctx


def setup_inputs(seed: int = 0) -> dict:
    key = jax.random.key(seed)
    ks = jax.random.split(key, 24)
    nrm = lambda k, shape, s: jax.random.normal(k, shape, jnp.float32) * s
    dt = jnp.exp(jax.random.uniform(ks[14], (DEPTH, 2, DN_HEADS), jnp.float32,
                                    minval=math.log(1e-3), maxval=math.log(1e-1)))
    return {
        'x_prompt': nrm(ks[0], (BATCH, SEQ, D_MODEL), 1.0),
        'x_sample': nrm(ks[1], (DEC_BATCH, DEC_SEQ, D_MODEL), 1.0),
        'cache_gqa_k': nrm(ks[2], (DEC_BATCH, DEPTH, PAST_LEN, GQA_KV_HEADS, HEAD_DIM), 1.0),
        'cache_gqa_v': nrm(ks[3], (DEC_BATCH, DEPTH, PAST_LEN, GQA_KV_HEADS, HEAD_DIM), 1.0),
        'cache_diff_k': nrm(ks[4], (DEC_BATCH, DEPTH, PAST_LEN, DIFF_HEADS, 2, HEAD_DIM), 1.0),
        'cache_diff_v': nrm(ks[5], (DEC_BATCH, DEPTH, PAST_LEN, DIFF_HEADS, 2 * HEAD_DIM), 1.0),
        'state_dn': nrm(ks[6], (DEC_BATCH, DEPTH, 2, DN_HEADS, DN_DK, DN_DV), 0.1),
        'c': nrm(ks[7], (DEC_BATCH, D_MODEL), 1.0),
        'c_ctx': nrm(ks[8], (D_MODEL,), 1.0),
        'w_mod': nrm(ks[9], (DEPTH, D_MODEL, 3 * D_MODEL), 0.5 * D_MODEL ** -0.5),
        'b_mod': nrm(ks[10], (DEPTH, 3 * D_MODEL), 0.01),
        'pre_norm_w': 1.0 + nrm(ks[11], (DEPTH, D_MODEL), 0.05),
        'post_norm_w': 1.0 + nrm(ks[12], (DEPTH, D_MODEL), 0.05),
        'w_in': nrm(ks[13], (DEPTH, D_MODEL, IN_COLS), D_MODEL ** -0.5),
        'w_out': nrm(ks[15], (DEPTH, MIX_W, D_MODEL), MIX_W ** -0.5),
        'dn_conv_w': nrm(ks[16], (DEPTH, CONV_K, 3 * DN_W), CONV_K ** -0.5),
        'dn_a_log': jnp.log(jax.random.uniform(ks[17], (DEPTH, 2, DN_HEADS), jnp.float32, minval=1.0, maxval=16.0)),
        'dn_dt_bias': dt + jnp.log(-jnp.expm1(-dt)),
        'dn_norm_w': 1.0 + nrm(ks[18], (DEPTH, DN_DV), 0.05),
        'gqa_q_norm_w': 1.0 + nrm(ks[19], (DEPTH, HEAD_DIM), 0.05),
        'gqa_k_norm_w': 1.0 + nrm(ks[20], (DEPTH, HEAD_DIM), 0.05),
        'diff_lambda': nrm(ks[21], (DEPTH, 4, HEAD_DIM), 0.1),
        'diff_norm_w': 1.0 + nrm(ks[22], (DEPTH, 2 * HEAD_DIM), 0.05),
    }


def reference(x_prompt, x_sample, cache_gqa_k, cache_gqa_v, cache_diff_k, cache_diff_v, state_dn,
              c, c_ctx, w_mod, b_mod, pre_norm_w, post_norm_w, w_in, w_out, dn_conv_w, dn_a_log,
              dn_dt_bias, dn_norm_w, gqa_q_norm_w, gqa_k_norm_w, diff_lambda, diff_norm_w):
    xp, xs = x_prompt, x_sample
    new_k, new_v, new_dk, new_dv, new_s = [], [], [], [], []
    for l in range(DEPTH):
        lambda_init = 0.8 - 0.6 * math.exp(-0.3 * l)
        weights = (pre_norm_w[l], post_norm_w[l], w_in[l], w_out[l], dn_conv_w[l], dn_a_log[l],
                   dn_dt_bias[l], dn_norm_w[l], gqa_q_norm_w[l], gqa_k_norm_w[l],
                   diff_lambda[l], diff_norm_w[l])
        xp, ctx_new = mixer_layer(xp, modulation(c_ctx, w_mod[l], b_mod[l]), weights, lambda_init, None)
        new_k.append(ctx_new[0])
        new_v.append(ctx_new[1])
        new_dk.append(ctx_new[2])
        new_dv.append(ctx_new[3])
        new_s.append(ctx_new[4])
        ctx_l = (cache_gqa_k[:, l], cache_gqa_v[:, l], cache_diff_k[:, l], cache_diff_v[:, l], state_dn[:, l])
        xs, _ = mixer_layer(xs, modulation(c[:, None, :], w_mod[l], b_mod[l]), weights, lambda_init, ctx_l)
    return (xp, xs, jnp.stack(new_k, axis=1), jnp.stack(new_v, axis=1), jnp.stack(new_dk, axis=1),
            jnp.stack(new_dv, axis=1), jnp.stack(new_s, axis=1))
```

```cpp
#include <hip/hip_runtime.h>
#include <cstdio>
#include <cstdint>
#include <cstring>

typedef unsigned short bf16_t;
#define LAS __attribute__((address_space(3)))

constexpr int DM = 4096;
constexpr int M_CTX = 16 * 256;
constexpr int M_LAT = 8 * 4096;
constexpr int M_ALL = M_CTX + M_LAT;
constexpr int IN_COLS = 13344;
constexpr int NPAD = 13568;
constexpr int ZA_W = 4096, ZB_W = 5120, ZC_W = 4096;
constexpr int MODW = 3 * DM;
constexpr float NORM_EPS = 1e-6f;
constexpr float ATT_SCALE = 0.088388347648318440f;

constexpr size_t MiB = (size_t)1 << 20;
constexpr size_t WS_CTL = 0;
constexpr size_t CTL_BYTES = 64 * 1024;
constexpr size_t WS_MOD = 1 * MiB;
constexpr size_t WS_ROPE = 2 * MiB;
constexpr size_t WS_CKM = WS_ROPE + 32768;
constexpr size_t WS_KP = WS_ROPE + 65536;
constexpr int KP_STRIDE = 288;
constexpr size_t WS_WINT = 3 * MiB;
constexpr size_t WS_WOUTT = WS_WINT + (size_t)2 * NPAD * DM * 2;
constexpr size_t WS_H = WS_WOUTT + (size_t)2 * DM * DM * 2;
constexpr size_t WS_ZA = WS_H + (size_t)M_ALL * DM * 2;
constexpr size_t WS_ZB = WS_ZA + (size_t)M_ALL * ZA_W * 2;
constexpr size_t WS_ZC = WS_ZB + (size_t)M_ALL * ZB_W * 2;
constexpr size_t WS_DTMP = WS_ZC + (size_t)M_ALL * ZC_W * 2;
constexpr size_t WS_AB = WS_DTMP + (size_t)2 * M_ALL * 1024 * 2;
constexpr size_t WS_CKG = WS_AB + (size_t)M_ALL * 32 * 4;
constexpr size_t WS_CVG = WS_CKG + (size_t)8 * 2 * 256 * 512 * 2;
constexpr size_t WS_CKD = WS_CVG + (size_t)8 * 2 * 256 * 512 * 2;
constexpr size_t WS_CVD = WS_CKD + (size_t)8 * 2 * 256 * 1024 * 2;
constexpr size_t WS_DNO = WS_CVD + (size_t)8 * 2 * 256 * 1024 * 2;
constexpr size_t WS_END = WS_DNO + (size_t)2 * M_ALL * 1024 * 4;
constexpr size_t WS_QKVR = WS_DNO;
constexpr int DN_UNIT = 73984, DNU_W = 0, DNU_Q = 16384, DNU_KT = 32768, DNU_QK = 49152, DNU_U = 57344, DNU_GC = 73728;
constexpr size_t WS_DNP = WS_ZB;
static_assert((size_t)9216 * DN_UNIT <= WS_AB - WS_ZB, "DNP overlay");
static_assert((size_t)M_ALL * 3072 * 2 <= (size_t)2 * M_ALL * 1024 * 4, "QKVR overlay");
constexpr size_t WS_O2 = WS_ZA;
static_assert(WS_END <= (size_t)2048 * MiB, "workspace");

constexpr size_t OUT_Y = 0;
constexpr size_t OUT_GK = (size_t)M_ALL * DM;
constexpr size_t OUT_GV = OUT_GK + (size_t)16 * 2 * 256 * 512;
constexpr size_t OUT_DK = OUT_GV + (size_t)16 * 2 * 256 * 512;
constexpr size_t OUT_DV = OUT_DK + (size_t)16 * 2 * 256 * 1024;
constexpr size_t OUT_ST = OUT_DV + (size_t)16 * 2 * 256 * 1024;

enum { IN_X_PROMPT, IN_X_SAMPLE, IN_CACHE_GQA_K, IN_CACHE_GQA_V, IN_CACHE_DIFF_K, IN_CACHE_DIFF_V, IN_STATE_DN, IN_C, IN_C_CTX, IN_W_MOD, IN_B_MOD, IN_PRE_W, IN_POST_W, IN_W_IN, IN_W_OUT, IN_CONV_W, IN_A_LOG, IN_DT_BIAS, IN_DN_NORM_W, IN_Q_NORM_W, IN_K_NORM_W, IN_DIFF_LAMBDA, IN_DIFF_NORM_W, IN_COUNT };
struct Params {
    const float* in[IN_COUNT];
    float* out;
    unsigned char* ws;
    int phase, layer;
};
constexpr int LDS_CTL_OFF = 146432;
constexpr int LDS_TAB_OFF = LDS_CTL_OFF + 64;
constexpr int LDS_BYTES = LDS_CTL_OFF + 1024;
__device__ __forceinline__ const float* inp(int idx) {
    extern __shared__ __attribute__((aligned(16))) unsigned char dyn_lds_[];
    const uint2 v = *(const uint2*)(dyn_lds_ + LDS_TAB_OFF + idx * 8);
    const unsigned lo = __builtin_amdgcn_readfirstlane(v.x), hi = __builtin_amdgcn_readfirstlane(v.y);
    return (const float*)(((unsigned long long)hi << 32) | (unsigned long long)lo);
}

__device__ __forceinline__ float bf2f(bf16_t b) { return __uint_as_float(((unsigned)b) << 16); }
__device__ __forceinline__ bf16_t f2bf(float f) { unsigned u = __float_as_uint(f); u += 0x7FFFu + ((u >> 16) & 1u); return (bf16_t)(u >> 16); }
__device__ __forceinline__ unsigned pk2bf(float lo, float hi) { return (unsigned)f2bf(lo) | ((unsigned)f2bf(hi) << 16); }
typedef float f32x2_t __attribute__((ext_vector_type(2)));
typedef __bf16 bf16x2_t __attribute__((ext_vector_type(2)));
__device__ __forceinline__ unsigned cvt_pk_rn(float lo, float hi) { const f32x2_t v = {lo, hi}; const bf16x2_t r = __builtin_convertvector(v, bf16x2_t); return __builtin_bit_cast(unsigned, r); }
__device__ __forceinline__ float shfl_xor_at(float v, int mask, int lane_l) { return __int_as_float(__builtin_amdgcn_ds_bpermute((lane_l ^ mask) << 2, __float_as_int(v))); }
__device__ __forceinline__ float shfl_up_at(float v, int d, int lane_l) { return __int_as_float(__builtin_amdgcn_ds_bpermute((lane_l - d) << 2, __float_as_int(v))); }
__device__ __forceinline__ float wave_sum_at(float v, int lane_l) {
#pragma unroll
    for (int o = 32; o >= 1; o >>= 1) v += shfl_xor_at(v, o, lane_l);
    return v;
}
#define wave_sum(v) wave_sum_at((v), lane)
#define __shfl_xor(v, m) shfl_xor_at((v), (m), lane)
#define __shfl_up(v, d) shfl_up_at((v), (d), lane)
__device__ __forceinline__ float silu_f(float x) { return x * __builtin_amdgcn_rcpf(1.0f + __expf(-x)); }
__device__ __forceinline__ int cond_of_row(int row) { return row < M_CTX ? 0 : 1 + ((row - M_CTX) >> 12); }

__device__ __forceinline__ int opaque_tid(int wv) { int l; asm volatile("v_mbcnt_lo_u32_b32 %0, -1, 0\n\tv_mbcnt_hi_u32_b32 %0, -1, %0" : "=v"(l)); return wv * 64 + l; }

#define XB_TMO      128
#define XB_XCNT(j)  (256  + 64 * (j))
#define XB_XSUB(j)  (1280 + 64 * (j))
#define XB_XGEN(j)  (2304 + 64 * (j))
#define XB_TOP      3328
#define XB_TOPGEN   3392
#define XCD_BAR_WORDS 3456
#define XB_SPIN_CAP (1u << 22)

__device__ __forceinline__ unsigned xb_ld(unsigned* p)              { return __hip_atomic_load(p, __ATOMIC_RELAXED, __HIP_MEMORY_SCOPE_AGENT); }
__device__ __forceinline__ unsigned xb_add(unsigned* p, unsigned v) { return __hip_atomic_fetch_add(p, v, __ATOMIC_RELAXED, __HIP_MEMORY_SCOPE_AGENT); }
__device__ __forceinline__ unsigned xb_xcc_id() { return (unsigned)__builtin_amdgcn_s_getreg((3 << 11) | 20) & 0xFu; }
#define XB_SPIN(cond, bar) do { unsigned _sp = 0; while (cond) { __builtin_amdgcn_s_sleep(1); \
    if ((++_sp & 255u) == 0u) { if (xb_ld(&(bar)[XB_TMO])) break; if (_sp > XB_SPIN_CAP) { atomicAdd(&(bar)[XB_TMO], 1u); break; } } } } while (0)

struct XcdBarrier {
    unsigned* bar; unsigned x;
    volatile LAS unsigned* st;
};

__device__ __forceinline__ XcdBarrier xcd_barrier_post(unsigned* bar, volatile LAS unsigned* st) {
    XcdBarrier b; b.bar = bar; b.x = xb_xcc_id(); b.st = st;
    if (threadIdx.x == 0) (void)xb_add(&bar[XB_XCNT(b.x)], 1u);
    return b;
}
__device__ __forceinline__ void xcd_barrier_complete(unsigned* bar, unsigned x, unsigned& nloc, unsigned& nx) {
    const unsigned G = gridDim.x * gridDim.y * gridDim.z;
    unsigned sum, cnt, mine, sp = 0u;
    for (;;) {
        sum = 0u; cnt = 0u; mine = 0u;
#pragma unroll
        for (unsigned j = 0; j < 16; ++j) { const unsigned c = xb_ld(&bar[XB_XCNT(j)]); sum += c; cnt += (c > 0u) ? 1u : 0u; mine = (j == x) ? c : mine; }
        if (sum == G) break;
        __builtin_amdgcn_s_sleep(1);
        if ((++sp & 255u) == 0u) { if (xb_ld(&bar[XB_TMO])) break; if (sp > XB_SPIN_CAP) { atomicAdd(&bar[XB_TMO], 1u); break; } }
    }
    nloc = mine > 0u ? mine : 1u; nx = cnt > 0u ? cnt : 1u;
}

__device__ __forceinline__ void xcd_barrier(const XcdBarrier& b) {
    asm volatile("s_waitcnt vmcnt(0)" ::: "memory");
    __syncthreads();
    if (threadIdx.x == 0) {
        unsigned blo = __builtin_amdgcn_readfirstlane((unsigned)(unsigned long long)b.bar), bhi = __builtin_amdgcn_readfirstlane((unsigned)((unsigned long long)b.bar >> 32)), bx = __builtin_amdgcn_readfirstlane(b.x);
        asm volatile("" : "+s"(blo), "+s"(bhi), "+s"(bx));
        unsigned* bar = (unsigned*)(((unsigned long long)bhi << 32) | (unsigned long long)blo);
        __builtin_amdgcn_s_waitcnt(0);
        unsigned nloc = b.st[0], nx = b.st[1];
        if (nloc == 0u) { xcd_barrier_complete(bar, bx, nloc, nx); b.st[0] = nloc; b.st[1] = nx; }
        const unsigned old = xb_add(&bar[XB_XSUB(bx)], 1u);
        const unsigned gen = old / nloc;
        if (old + 1u == (gen + 1u) * nloc) {
            __builtin_amdgcn_fence(__ATOMIC_RELEASE, "agent");
            asm volatile("s_waitcnt vmcnt(0)" ::: "memory");
            const unsigned og = xb_add(&bar[XB_TOP], 1u);
            const unsigned tg = og / nx;
            if (og + 1u == (tg + 1u) * nx) xb_add(&bar[XB_TOPGEN], 1u);
            else XB_SPIN(xb_ld(&bar[XB_TOPGEN]) == tg, bar);
            __builtin_amdgcn_fence(__ATOMIC_ACQUIRE, "agent");
            xb_add(&bar[XB_XGEN(bx)], 1u);
            asm volatile("s_waitcnt vmcnt(0)" ::: "memory");
        } else {
            XB_SPIN(xb_ld(&bar[XB_XGEN(bx)]) == gen, bar);
            __builtin_amdgcn_fence(__ATOMIC_ACQUIRE, "agent");
            asm volatile("s_waitcnt vmcnt(0)" ::: "memory");
        }
    }
    __syncthreads();
}
namespace pg8 {
#define PG8_LAS __attribute__((address_space(3)))
typedef unsigned short bf16_t;
typedef short bf16x8 __attribute__((ext_vector_type(8)));
typedef float f32x4 __attribute__((ext_vector_type(4)));
typedef unsigned u32x4 __attribute__((ext_vector_type(4)));
constexpr int BM = 256, BK = 64, HALF = 128, HTB = HALF * BK * 2  , STAGE_BYTES = 8 * HTB, NXCD = 8, WGM = 4;

__host__ __device__ __forceinline__ int lds_byte(int r, int c) { const int st = (r >> 4) * 2 + (c >> 5), rr = r & 15, cc = c & 31, ob = rr * 64 + cc * 2; return st * 1024 + (ob ^ (((ob >> 9) & 1) << 5)); }
__host__ __device__ __forceinline__ void stage_rc(int b, int& R, int& C) { const int st = b / 1024, sb = b % 1024, swz = sb ^ (((sb >> 9) & 1) << 5); R = (st >> 1) * 16 + swz / 64; C = (st & 1) * 32 + (swz % 64) / 2; }
__host__ __device__ __forceinline__ int perm32(int rho) { const int n = rho >> 4, i = rho & 15; return 8 * (i >> 2) + 4 * n + (i & 3); }

struct Unit { int pm, pn; };
struct Gemm { const bf16_t* A; const bf16_t* Bt; int M, N, K; };

struct StaticOrder {
    int nM, nN, nwg, G, c, nch;
    __host__ __device__ void init(int M, int N, int G_, int c_, int nch_ = 1) { nM = M / BM; nN = N / BM; nwg = nM * nN; G = G_; c = c_; nch = nch_; }
    __host__ __device__ bool next(int i, Unit& u) const {
        long L = (long)i * G + c; if (L >= nwg) return false;
        const int base = nN / nch, extra = nN % nch; int off = 0, wN = base + (extra > 0 ? 1 : 0);
        for (int ch = 0; ch < nch; ++ch) { wN = base + (ch < extra ? 1 : 0); const long cnt = (long)nM * wN; if (L < cnt) break; L -= cnt; off += wN; }
        const int nwc = nM * wN;
        int wgid = (int)L; { const int q = nwc / NXCD, r = nwc % NXCD, xcd = wgid % NXCD, o2 = wgid / NXCD; wgid = (xcd < r ? xcd * (q + 1) : r * (q + 1) + (xcd - r) * q) + o2; }
        const int nig = WGM * wN, gid = wgid / nig, fm = gid * WGM, gsz = (nM - fm) < WGM ? (nM - fm) : WGM;
        u.pm = fm + ((wgid % nig) % gsz); u.pn = off + (wgid % nig) / gsz; return true;
    }
    __device__ __forceinline__ void a_ready(const Unit&) const {}
    __device__ __forceinline__ void done(const Unit&) const {}
};

__device__ __forceinline__ unsigned cvt_pk_bf16(float lo, float hi) { return cvt_pk_rn(lo, hi); }

struct EpiF32 {
    static constexpr bool PERM = false, AFTER_DRAIN = false;
    float* C; int ldc;
    __device__ __forceinline__ void operator()(const f32x4 (&acc)[2][2][4][2], const Unit& u, int wr, int wc, int fr, int fq) const {
        const int row0 = u.pm * BM + wr * 64 + fr, col0 = u.pn * BM + wc * 32 + 4 * fq;
#pragma unroll
        for (int ai = 0; ai < 2; ++ai)
#pragma unroll
            for (int m = 0; m < 4; ++m) { float* rowp = C + (size_t)(row0 + ai * HALF + m * 16) * ldc + col0;
#pragma unroll
                for (int bj = 0; bj < 2; ++bj)
#pragma unroll
                    for (int n = 0; n < 2; ++n) *(f32x4*)(rowp + bj * HALF + n * 16) = acc[ai][bj][m][n]; }
    }
};
struct EpiB16 {
    static constexpr bool PERM = true, AFTER_DRAIN = false;
    bf16_t* O; int ld;
    __device__ __forceinline__ void operator()(const f32x4 (&acc)[2][2][4][2], const Unit& u, int wr, int wc, int fr, int fq) const {
        const int row0 = u.pm * BM + wr * 64 + fr, col0 = u.pn * BM + wc * 32 + 8 * fq;
#pragma unroll
        for (int ai = 0; ai < 2; ++ai)
#pragma unroll
            for (int m = 0; m < 4; ++m) { bf16_t* rowp = O + (size_t)(row0 + ai * HALF + m * 16) * ld + col0;
#pragma unroll
                for (int bj = 0; bj < 2; ++bj) { const f32x4 v0 = acc[ai][bj][m][0], v1 = acc[ai][bj][m][1];
                    u32x4 w; w.x = cvt_pk_bf16(v0[0], v0[1]); w.y = cvt_pk_bf16(v0[2], v0[3]); w.z = cvt_pk_bf16(v1[0], v1[1]); w.w = cvt_pk_bf16(v1[2], v1[3]);
                    *(u32x4*)(rowp + bj * HALF) = w; } }
    }
};
struct EpiZ {
    static constexpr bool PERM = true, AFTER_DRAIN = false;
    bf16_t *ZA, *ZB, *ZC; float* AB;
    __device__ __forceinline__ void operator()(const f32x4 (&acc)[2][2][4][2], const Unit& u, int wr, int wc, int fr, int fq) const {
        const int row0 = u.pm * BM + wr * 64 + fr;
        if (u.pn < 52) {
            bf16_t* base; int ld, colt;
            if (u.pn < 16) { base = ZA; ld = 4096; colt = u.pn * BM; }
            else if (u.pn < 36) { base = ZB; ld = 5120; colt = (u.pn - 16) * BM; }
            else { base = ZC; ld = 4096; colt = (u.pn - 36) * BM; }
            const int col0 = colt + wc * 32 + 8 * fq;
#pragma unroll
            for (int ai = 0; ai < 2; ++ai)
#pragma unroll
                for (int m = 0; m < 4; ++m) { bf16_t* rowp = base + (size_t)(row0 + ai * HALF + m * 16) * ld + col0;
#pragma unroll
                    for (int bj = 0; bj < 2; ++bj) { const f32x4 v0 = acc[ai][bj][m][0], v1 = acc[ai][bj][m][1];
                        u32x4 w; w.x = cvt_pk_bf16(v0[0], v0[1]); w.y = cvt_pk_bf16(v0[2], v0[3]); w.z = cvt_pk_bf16(v1[0], v1[1]); w.w = cvt_pk_bf16(v1[2], v1[3]);
                        *(u32x4*)(rowp + bj * HALF) = w; } }
        } else if (wc == 0) {
#pragma unroll
            for (int ai = 0; ai < 2; ++ai)
#pragma unroll
                for (int m = 0; m < 4; ++m) { float* rowp = AB + (size_t)(row0 + ai * HALF + m * 16) * 32 + 8 * fq;
                    *(f32x4*)(rowp) = acc[ai][0][m][0]; *(f32x4*)(rowp + 4) = acc[ai][0][m][1]; }
        }
    }
};


template <class Epi, class Sched, bool ALIGN_EPI = true, bool SP2 = true>
__device__ __forceinline__ void gemm_phase(PG8_LAS unsigned char* lds, const Gemm g, const Sched& S, const Epi& E, int wv) {
    const int tid = opaque_tid(wv), wid = __builtin_amdgcn_readfirstlane(tid >> 6), lane = tid & 63, wr = wid >> 2, wc = wid & 3, fr = lane & 15, fq = lane >> 4;
    const int K = g.K, nt = K / BK;
    unsigned voffA[2], voffB[2];
#pragma unroll
    for (int i = 0; i < 2; ++i) { int R, C; stage_rc(tid * 16 + i * 8192, R, C); const int Rb = Epi::PERM ? ((R & ~31) + perm32(R & 31)) : R;
        voffA[i] = (unsigned)(R * K + C) * 2u; voffB[i] = (unsigned)(Rb * K + C) * 2u; }
    const size_t kstep = (size_t)(BK * 2);
    const size_t hstep = (size_t)HALF * K * 2;
    const size_t tstep = 2 * hstep;
    const unsigned ldsw = (unsigned)wid * 1024u;
    const int aoff = lds_byte(wr * 64 + fr, fq * 8), boff = lds_byte(wc * 32 + fr, fq * 8);
#define PG8_SA(b, h) (((b) * 2 + (h)) * HTB)
#define PG8_SB(b, h) ((4 + (b) * 2 + (h)) * HTB)
#define PG8_STAGE(bufoff, gbase, voff) do { _Pragma("unroll") for (int _i = 0; _i < 2; ++_i) \
        __builtin_amdgcn_global_load_lds((const unsigned*)((const char*)(gbase) + (voff)[_i]), (PG8_LAS unsigned*)(lds + (bufoff) + ldsw + _i * 8192), 16, 0, 0); } while (0)
#define PG8_LDA(dst, b, h) do { _Pragma("unroll") for (int m = 0; m < 4; ++m) _Pragma("unroll") for (int k = 0; k < 2; ++k) dst[m][k] = *(const PG8_LAS bf16x8*)(lds + PG8_SA(b, h) + aoff + m * 2048 + k * 1024); } while (0)
#define PG8_LDB(dst, b, h) do { _Pragma("unroll") for (int n = 0; n < 2; ++n) _Pragma("unroll") for (int k = 0; k < 2; ++k) dst[n][k] = *(const PG8_LAS bf16x8*)(lds + PG8_SB(b, h) + boff + n * 2048 + k * 1024); } while (0)
#define PG8_MMA(ai, bj, At, Bt) do { __builtin_amdgcn_s_setprio(1); _Pragma("unroll") for (int m = 0; m < 4; ++m) _Pragma("unroll") for (int n = 0; n < 2; ++n) _Pragma("unroll") for (int k = 0; k < 2; ++k) \
        acc[ai][bj][m][n] = __builtin_amdgcn_mfma_f32_16x16x32_bf16(Bt[n][k], At[m][k], acc[ai][bj][m][n], 0, 0, 0); __builtin_amdgcn_s_setprio(0); } while (0)
#define PG8_WAIT_V(n) asm volatile("s_waitcnt vmcnt(" #n ")" ::: "memory")
#define PG8_WAIT_L(n) asm volatile("s_waitcnt lgkmcnt(" #n ")" ::: "memory")
#define PG8_BAR __builtin_amdgcn_s_barrier()
#define PG8_SCHED __builtin_amdgcn_sched_barrier(0)
    Unit cur, nxt; int ui = 0;
    if (!S.next(0, cur)) return;
    f32x4 acc[2][2][4][2];
#pragma unroll
    for (int a = 0; a < 2; ++a)
#pragma unroll
        for (int b = 0; b < 2; ++b)
#pragma unroll
            for (int m = 0; m < 4; ++m)
#pragma unroll
                for (int n = 0; n < 2; ++n) acc[a][b][m][n] = (f32x4){0.f, 0.f, 0.f, 0.f};
    bf16x8 At[4][2], B0[2][2], B1[2][2];
    const char* cA = (const char*)g.A + (size_t)cur.pm * tstep; const char* cB = (const char*)g.Bt + (size_t)cur.pn * tstep;
    S.a_ready(cur);
    if constexpr (SP2) {
        PG8_STAGE(PG8_SB(0, 0), cB, voffB); PG8_STAGE(PG8_SB(0, 1), cB + hstep, voffB); PG8_STAGE(PG8_SA(0, 0), cA, voffA); PG8_STAGE(PG8_SA(0, 1), cA + hstep, voffA);
        if (wr == 1) PG8_BAR;
        PG8_WAIT_V(2); PG8_BAR;
        PG8_STAGE(PG8_SB(1, 0), cB + kstep, voffB); PG8_STAGE(PG8_SA(1, 0), cA + kstep, voffA); PG8_STAGE(PG8_SB(1, 1), cB + hstep + kstep, voffB);
        PG8_WAIT_V(6); PG8_BAR;
    } else {
        PG8_STAGE(PG8_SB(0, 0), cB, voffB); PG8_STAGE(PG8_SA(0, 0), cA, voffA); PG8_STAGE(PG8_SB(0, 1), cB + hstep, voffB); PG8_STAGE(PG8_SA(0, 1), cA + hstep, voffA);
        if (wr == 1) PG8_BAR;
        PG8_WAIT_V(4); PG8_BAR;
        PG8_STAGE(PG8_SB(1, 0), cB + kstep, voffB); PG8_STAGE(PG8_SA(1, 0), cA + kstep, voffA); PG8_STAGE(PG8_SB(1, 1), cB + hstep + kstep, voffB);
        PG8_WAIT_V(6); PG8_BAR;
    }
    for (;;) {
        const bool has_next = S.next(ui + 1, nxt);
        const char* nA = has_next ? (const char*)g.A + (size_t)nxt.pm * tstep : cA; const char* nB = has_next ? (const char*)g.Bt + (size_t)nxt.pn * tstep : cB;
        for (int t = 0; t < nt; t += 2) {
            const bool last = (t == nt - 2);
            const char* a1 = cA + (size_t)(t + 1) * kstep;
            const char* a2 = last ? nA : cA + (size_t)(t + 2) * kstep; const char* b2 = last ? nB : cB + (size_t)(t + 2) * kstep;
            const char* a3 = a2 + kstep; const char* b3 = b2 + kstep;
            if (last && has_next) S.a_ready(nxt);
            if constexpr (SP2) {
            PG8_LDB(B0, 0, 0); PG8_LDB(B1, 0, 1); PG8_SCHED; PG8_LDA(At, 0, 0); PG8_STAGE(PG8_SA(1, 1), a1 + hstep, voffA);
            PG8_WAIT_V(8); PG8_WAIT_L(0); PG8_BAR; PG8_MMA(0, 0, At, B0); PG8_MMA(0, 1, At, B1); PG8_BAR; PG8_SCHED;
            PG8_LDA(At, 0, 1); PG8_STAGE(PG8_SB(0, 0), b2, voffB); PG8_STAGE(PG8_SB(0, 1), b2 + hstep, voffB); PG8_STAGE(PG8_SA(0, 0), a2, voffA);
            PG8_WAIT_V(8); PG8_WAIT_L(0); PG8_BAR; PG8_MMA(1, 0, At, B0); PG8_MMA(1, 1, At, B1); PG8_BAR; PG8_SCHED;
            PG8_LDB(B0, 1, 0); PG8_LDB(B1, 1, 1); PG8_SCHED; PG8_LDA(At, 1, 0); PG8_STAGE(PG8_SA(0, 1), a2 + hstep, voffA);
            PG8_WAIT_V(8); PG8_WAIT_L(0); PG8_BAR; PG8_MMA(0, 0, At, B0); PG8_MMA(0, 1, At, B1); PG8_BAR; PG8_SCHED;
            PG8_LDA(At, 1, 1); PG8_STAGE(PG8_SB(1, 0), b3, voffB); PG8_STAGE(PG8_SB(1, 1), b3 + hstep, voffB); PG8_STAGE(PG8_SA(1, 0), a3, voffA);
            PG8_WAIT_V(8); PG8_WAIT_L(0); PG8_BAR; PG8_MMA(1, 0, At, B0); PG8_MMA(1, 1, At, B1); PG8_BAR; PG8_SCHED;
            } else {
            PG8_LDB(B0, 0, 0); PG8_SCHED; PG8_LDA(At, 0, 0); PG8_STAGE(PG8_SA(1, 1), a1 + hstep, voffA);
            PG8_WAIT_L(8); PG8_BAR; PG8_WAIT_L(0); PG8_MMA(0, 0, At, B0); PG8_BAR; PG8_SCHED;
            PG8_LDB(B1, 0, 1); PG8_STAGE(PG8_SB(0, 0), b2, voffB);
            PG8_BAR; PG8_WAIT_L(0); PG8_MMA(0, 1, At, B1); PG8_BAR;
            PG8_LDA(At, 0, 1); PG8_STAGE(PG8_SA(0, 0), a2, voffA);
            PG8_BAR; PG8_WAIT_L(0); PG8_MMA(1, 0, At, B0); PG8_BAR; PG8_SCHED;
            PG8_STAGE(PG8_SB(0, 1), b2 + hstep, voffB);
            PG8_WAIT_V(6); PG8_BAR; PG8_MMA(1, 1, At, B1); PG8_BAR;
            PG8_LDB(B0, 1, 0); PG8_SCHED; PG8_LDA(At, 1, 0); PG8_STAGE(PG8_SA(0, 1), a2 + hstep, voffA);
            PG8_WAIT_L(8); PG8_BAR; PG8_WAIT_L(0); PG8_MMA(0, 0, At, B0); PG8_BAR; PG8_SCHED;
            PG8_LDB(B1, 1, 1); PG8_STAGE(PG8_SB(1, 0), b3, voffB);
            PG8_BAR; PG8_WAIT_L(0); PG8_MMA(0, 1, At, B1); PG8_BAR;
            PG8_LDA(At, 1, 1); PG8_STAGE(PG8_SA(1, 0), a3, voffA);
            PG8_BAR; PG8_WAIT_L(0); PG8_MMA(1, 0, At, B0); PG8_BAR; PG8_SCHED;
            PG8_STAGE(PG8_SB(1, 1), b3 + hstep, voffB);
            PG8_WAIT_V(6); PG8_BAR; PG8_MMA(1, 1, At, B1); PG8_BAR;
            }
        }
        if constexpr (ALIGN_EPI) { if (wr == 0) PG8_BAR; }
        if constexpr (!Epi::AFTER_DRAIN) { E(acc, cur, wr, wc, fr, fq); S.done(cur); }
        if (!has_next) break;
#pragma unroll
        for (int a = 0; a < 2; ++a)
#pragma unroll
            for (int b = 0; b < 2; ++b)
#pragma unroll
                for (int m = 0; m < 4; ++m)
#pragma unroll
                    for (int n = 0; n < 2; ++n) acc[a][b][m][n] = (f32x4){0.f, 0.f, 0.f, 0.f};
        cur = nxt; cA = nA; cB = nB; ++ui;
        if constexpr (ALIGN_EPI) { if (wr == 1) PG8_BAR; }
    }
    PG8_WAIT_V(0);
    if constexpr (!ALIGN_EPI) { if (wr == 0) PG8_BAR; }
    PG8_BAR;
    if constexpr (Epi::AFTER_DRAIN) { E.fused(acc, cur, wr, wc, fr, fq, lds, wid, lane); S.done(cur); }
#undef PG8_SA
#undef PG8_SB
#undef PG8_STAGE
#undef PG8_LDA
#undef PG8_LDB
#undef PG8_MMA
#undef PG8_WAIT_V
#undef PG8_WAIT_L
#undef PG8_BAR
#undef PG8_SCHED
}
}

namespace att {
constexpr int D = 128, NW = 8, QBLK = 32, KVBLK = 64;
constexpr float SCALE = 0.088388347648318440f;
constexpr size_t SHM_V = KVBLK * D * 2, SHM_K = KVBLK * D * 2, VSL = 2 * SHM_V, SHM_ATTN = 2 * VSL + 2 * SHM_K + NW * 64 * 4;
using bf16x8 = __attribute__((ext_vector_type(8))) short;
using s16x4  = __attribute__((ext_vector_type(4))) short;
using f32x16 = __attribute__((ext_vector_type(16))) float;
using u32x4  = __attribute__((ext_vector_type(4))) unsigned;
#define KSWZ(row, colB) ((row) * 256 + ((colB) ^ (((row) & 7) << 4)))
#define SBAR() __builtin_amdgcn_sched_barrier(0)
__device__ __forceinline__ int crow(int r, int hi) { return (r & 3) + 8 * (r >> 2) + 4 * hi; }
__device__ __forceinline__ unsigned cvtpk(float lo, float hi) {
  unsigned r; asm volatile("v_cvt_pk_bf16_f32 %0, %1, %2" : "=v"(r) : "v"(lo), "v"(hi)); return r;
}
__device__ __forceinline__ void partialSM(f32x16& p0, f32x16& p1, float mnC, bool shift) {
  if (shift) {
#pragma unroll
    for (int r = 0; r < 16; ++r) { p0[r] += mnC; p1[r] += mnC; } }
#pragma unroll
  for (int r = 0; r < 16; ++r) p0[r] = __builtin_amdgcn_exp2f(p0[r]);
}
__device__ __forceinline__ void finishSM(f32x16& p0, f32x16& p1, float& l_reg, bf16x8& pa0, bf16x8& pa1, bf16x8& pa2, bf16x8& pa3) {
#pragma unroll
  for (int r = 0; r < 16; ++r) p1[r] = __builtin_amdgcn_exp2f(p1[r]);
  float ps = 0;
#pragma unroll
  for (int r = 0; r < 16; ++r) ps += p0[r];
#pragma unroll
  for (int r = 0; r < 16; ++r) ps += p1[r];
  { auto rr = __builtin_amdgcn_permlane32_swap(__float_as_uint(ps), __float_as_uint(ps), false, false);
    ps = __uint_as_float(rr[0]) + __uint_as_float(rr[1]); }
  l_reg += ps;
#define PK4(P, BASE, OUT) do { unsigned a0 = cvtpk(P[BASE + 0], P[BASE + 1]), a1 = cvtpk(P[BASE + 2], P[BASE + 3]);   \
    unsigned b0 = cvtpk(P[BASE + 4], P[BASE + 5]), b1 = cvtpk(P[BASE + 6], P[BASE + 7]);                              \
    auto r0 = __builtin_amdgcn_permlane32_swap(a0, b0, false, false); auto r1 = __builtin_amdgcn_permlane32_swap(a1, b1, false, false); \
    u32x4 w = {r0[0], r1[0], r0[1], r1[1]}; OUT = *reinterpret_cast<bf16x8*>(&w); } while (0)
  PK4(p0, 0, pa0); PK4(p0, 8, pa1); PK4(p1, 0, pa2); PK4(p1, 8, pa3);
#undef PK4
}
__device__ __forceinline__ void qkt(f32x16& p0, f32x16& p1, const bf16_t* Ks, const bf16x8* qr, int r32, int hi) {
  p0 = f32x16{}; p1 = f32x16{};
#pragma unroll
  for (int d0 = 0; d0 < 8; ++d0) { int cb = (d0 * 16 + hi * 8) * 2;
    bf16x8 b0 = *reinterpret_cast<const bf16x8*>((const char*)Ks + KSWZ(r32, cb));
    bf16x8 b1 = *reinterpret_cast<const bf16x8*>((const char*)Ks + KSWZ(32 + r32, cb));
    p0 = __builtin_amdgcn_mfma_f32_32x32x16_bf16(b0, qr[d0], p0, 0, 0, 0);
    p1 = __builtin_amdgcn_mfma_f32_32x32x16_bf16(b1, qr[d0], p1, 0, 0, 0); }
}
__device__ __forceinline__ int v_st(int k, int c) { const int kk = (k & ~0xC) | ((k & 4) << 1) | ((k & 8) >> 1); return ((kk >> 3) * 4 + (c >> 5)) * 512 + ((kk & 7) * 32 + (c & 31)) * 2; }
__device__ __forceinline__ int v_rd_base(int lane) { return ((lane & 3) << 3) | (((lane >> 2) & 3) << 6) | (((lane >> 4) & 1) << 5) | (((lane >> 5) & 1) << 8); }
constexpr int v_rd_off(int d0, int ks, int half) { return d0 * 512 + ks * 4096 + half * 2048; }
template <int OFF> __device__ __forceinline__ s16x4 tr_read(int vb) {
  s16x4 r; asm volatile("ds_read_b64_tr_b16 %0, %1 offset:%2" : "=&v"(r) : "v"(vb), "i"(OFF) : "memory"); return r;
}
template <int D0> __device__ __forceinline__ void pv_one(f32x16& od, int vb, bf16x8 pa0, bf16x8 pa1, bf16x8 pa2, bf16x8 pa3) {
  const s16x4 l0 = tr_read<v_rd_off(D0, 0, 0)>(vb), h0 = tr_read<v_rd_off(D0, 0, 1)>(vb), l1 = tr_read<v_rd_off(D0, 1, 0)>(vb), h1 = tr_read<v_rd_off(D0, 1, 1)>(vb);
  const s16x4 l2 = tr_read<v_rd_off(D0, 2, 0)>(vb), h2 = tr_read<v_rd_off(D0, 2, 1)>(vb), l3 = tr_read<v_rd_off(D0, 3, 0)>(vb), h3 = tr_read<v_rd_off(D0, 3, 1)>(vb);
  asm volatile("s_waitcnt lgkmcnt(0)" ::: "memory"); SBAR();
#define PK(L, H) (bf16x8){L[0], L[1], L[2], L[3], H[0], H[1], H[2], H[3]}
  od = __builtin_amdgcn_mfma_f32_32x32x16_bf16(pa0, PK(l0, h0), od, 0, 0, 0);
  od = __builtin_amdgcn_mfma_f32_32x32x16_bf16(pa1, PK(l1, h1), od, 0, 0, 0);
  od = __builtin_amdgcn_mfma_f32_32x32x16_bf16(pa2, PK(l2, h2), od, 0, 0, 0);
  od = __builtin_amdgcn_mfma_f32_32x32x16_bf16(pa3, PK(l3, h3), od, 0, 0, 0);
#undef PK
}
__device__ __forceinline__ void pv_d0(f32x16* o, int vb, bf16x8 pa0, bf16x8 pa1, bf16x8 pa2, bf16x8 pa3) {
  pv_one<0>(o[0], vb, pa0, pa1, pa2, pa3); pv_one<1>(o[1], vb, pa0, pa1, pa2, pa3); pv_one<2>(o[2], vb, pa0, pa1, pa2, pa3); pv_one<3>(o[3], vb, pa0, pa1, pa2, pa3);
}

__device__ __forceinline__ bf16x8 ldb128(__amdgpu_buffer_rsrc_t r, unsigned voff, unsigned soff) {
  u32x4 v = __builtin_amdgcn_raw_buffer_load_b128(r, (int)voff, (int)soff, 0); return *reinterpret_cast<bf16x8*>(&v);
}
typedef LAS const char* lds_cptr;
typedef short v4i16_t __attribute__((ext_vector_type(4)));
typedef unsigned u32x2_t __attribute__((ext_vector_type(2)));
#define PIN(x) asm volatile("" : "+v"(x))
#define MFMA32(a, b, c) __builtin_amdgcn_mfma_f32_32x32x16_bf16((a), (b), (c), 0, 0, 0)
__device__ __forceinline__ s16x4 vtr(lds_cptr p) { return __builtin_bit_cast(s16x4, __builtin_amdgcn_ds_read_tr16_b64_v4i16((LAS v4i16_t*)p)); }
__device__ __forceinline__ bf16x8 kfrag(const lds_cptr (&kp)[8], int g, int ks) { return *(const LAS bf16x8*)(kp[g >> 1] + (ks + (g & 1) * 8192)); }
__device__ __forceinline__ void vfrag(s16x4& lo, s16x4& hi, lds_cptr vp, int g, int vs) { lo = vtr(vp + (vs + (g & 3) * 512 + (g >> 2) * 4096)); hi = vtr(vp + (vs + (g & 3) * 512 + (g >> 2) * 4096 + 2048)); }
template <bool SH> __device__ __forceinline__ float ex2(float v, float nm) { return __builtin_amdgcn_exp2f(SH ? v + nm : v); }
constexpr int FW = 6;
template <int NV, int F, int KS, int VS> __device__ __forceinline__ u32x4 mfrag(lds_cptr vp, const lds_cptr (&kp)[8]) {
  if constexpr (F < 16 * NV) { s16x4 lo, hi; vfrag(lo, hi, vp, F & 15, VS + (F >> 4) * (int)SHM_V); const u32x2_t a = __builtin_bit_cast(u32x2_t, lo), b = __builtin_bit_cast(u32x2_t, hi); return (u32x4){a[0], a[1], b[0], b[1]}; }
  else return __builtin_bit_cast(u32x4, kfrag(kp, F - 16 * NV, KS));
}
template <int NV, int G, int NG, int F0, int KS, int VS> __device__ __forceinline__ void gapM(f32x16 (&o)[4 * NV], const u32x4 (&pw)[4], f32x16& C0, f32x16& C1, const bf16x8 (&qr)[8], u32x4 (&fw)[FW],
    lds_cptr vp, const lds_cptr (&kp)[8]) {
  if constexpr (G + FW - 1 < NG) fw[(G + FW - 1) % FW] = mfrag<NV, F0 + G + FW - 1, KS, VS>(vp, kp);
  constexpr int F = F0 + G;
  if constexpr (F < 16 * NV) o[(F >> 4) * 4 + (F & 3)] = MFMA32(__builtin_bit_cast(bf16x8, pw[(F & 15) >> 2]), __builtin_bit_cast(bf16x8, fw[G % FW]), o[(F >> 4) * 4 + (F & 3)]);
  else { constexpr int g = F - 16 * NV;
    if constexpr ((g & 1) == 0) { if constexpr (g < 2) C0 = MFMA32(__builtin_bit_cast(bf16x8, fw[G % FW]), qr[g >> 1], f32x16{}); else C0 = MFMA32(__builtin_bit_cast(bf16x8, fw[G % FW]), qr[g >> 1], C0); }
    else { if constexpr (g < 2) C1 = MFMA32(__builtin_bit_cast(bf16x8, fw[G % FW]), qr[g >> 1], f32x16{}); else C1 = MFMA32(__builtin_bit_cast(bf16x8, fw[G % FW]), qr[g >> 1], C1); } }
  SBAR();
}
template <int NV, int G, int NG, int F0, int KS, int VS> struct MSeg {
  static __device__ __forceinline__ void run(f32x16 (&o)[4 * NV], const u32x4 (&pw)[4], f32x16& C0, f32x16& C1, const bf16x8 (&qr)[8], u32x4 (&fw)[FW], lds_cptr vp, const lds_cptr (&kp)[8]) {
    if constexpr (G == 0) {
      fw[0] = mfrag<NV, F0 + 0, KS, VS>(vp, kp); fw[1] = mfrag<NV, F0 + 1, KS, VS>(vp, kp); fw[2] = mfrag<NV, F0 + 2, KS, VS>(vp, kp); fw[3] = mfrag<NV, F0 + 3, KS, VS>(vp, kp); fw[4] = mfrag<NV, F0 + 4, KS, VS>(vp, kp);
      static_assert(FW == 6, "prefetch list"); SBAR(); }
    gapM<NV, G, NG, F0, KS, VS>(o, pw, C0, C1, qr, fw, vp, kp);
    if constexpr (G + 1 < NG) MSeg<NV, G + 1, NG, F0, KS, VS>::run(o, pw, C0, C1, qr, fw, vp, kp);
  }
};
__device__ __forceinline__ void dma16(u32x4 rsrc, unsigned voff, unsigned soff, unsigned lds_addr) {
  unsigned sv; asm volatile("s_mov_b32 %0, m0\n\ts_mov_b32 m0, %4\n\ts_nop 0\n\tbuffer_load_dwordx4 %1, %2, %3 offen lds\n\ts_mov_b32 m0, %0" : "=&s"(sv) : "v"(voff), "s"(rsrc), "s"(soff), "s"(lds_addr) : "memory"); }
struct Unit {
  const bf16_t* Q; const bf16_t* K1; const bf16_t* V1; const bf16_t* K2; const bf16_t* V2; bf16_t* O; const bf16_t* G;
  const float* qw;
  const float* rope;
  const float* kp;
  float kcm;
  int ldq, ld1, n1, ld2, n2, ldo, ldg, t0;
};
template <int NV> __device__ __forceinline__ void attn_unit(const Unit& U, char* lds, int wv) {
  const int tid = opaque_tid(wv), wid = wv, lane = tid & 63, r32 = lane & 31, hi = lane >> 5;
  bf16_t* V_lds = (bf16_t*)lds; bf16_t* K_lds = (bf16_t*)(lds + 2 * VSL);
  float* ws = (float*)(lds + 2 * VSL + 2 * SHM_K) + wid * 64; float* li_l = ws;
  float l_reg = 0, mnC; f32x16 o[4 * NV] = {}; bf16x8 qr[8];
  const bf16_t* Qw = U.Q + (long)(wid * QBLK + r32) * U.ldq + hi * 8;
#pragma unroll
  for (int d0 = 0; d0 < 8; ++d0) qr[d0] = *reinterpret_cast<const bf16x8*>(Qw + d0 * 16);
  const int vb0 = (int)(uintptr_t)V_lds + v_rd_base(lane);
  const int n1 = U.n1;
  const unsigned krow = (unsigned)(wv * 8 + (lane >> 4)), kc16 = (unsigned)(((lane & 15) ^ ((wv & 1) * 8 + (lane >> 4))) << 4);
  const unsigned vkk = (unsigned)(wv * 8 + ((lane & 31) >> 2)), vrow = vkk, vcb = (unsigned)((lane >> 5) * 64 + (lane & 3) * 16);
  const unsigned kdst = (unsigned)(uintptr_t)K_lds + (unsigned)wv * 2048u, vdst = (unsigned)(uintptr_t)V_lds + (unsigned)wv * 2048u;
#define BSYNC() do { SBAR(); __syncthreads(); SBAR(); } while (0)
#define DSYNC() do { SBAR(); asm volatile("s_waitcnt vmcnt(0)" ::: "memory"); __syncthreads(); SBAR(); } while (0)
#define RSRC(p) (u32x4){(unsigned)(uintptr_t)(p), (unsigned)((uintptr_t)(p) >> 32) & 0xffffu, 0x7fffffffu, 0x00020000u}
#define DMA_K(t, slot) do { const int _k0 = (t) * KVBLK; const bool _s1 = _k0 < n1; const u32x4 _r = RSRC(_s1 ? U.K1 : U.K2);                                  \
    const unsigned _ldb = (unsigned)(_s1 ? U.ld1 : U.ld2) * 2u, _so = (unsigned)(_s1 ? _k0 : _k0 - n1) * _ldb, _v = krow * _ldb + kc16;  \
    dma16(_r, _v, _so, kdst + (slot) * (unsigned)SHM_K); dma16(_r, _v ^ 64u, _so + 4u * _ldb, kdst + (slot) * (unsigned)SHM_K + 1024u); } while (0)
#define DMA_V(t, slot) do { const int _k0 = (t) * KVBLK; const bool _s1 = _k0 < n1; const u32x4 _r = RSRC(_s1 ? U.V1 : U.V2);                                  \
    const unsigned _ldb = (unsigned)(_s1 ? U.ld1 : U.ld2) * 2u, _so = (unsigned)(_s1 ? _k0 : _k0 - n1) * _ldb, _v = vrow * _ldb + vcb;   \
    _Pragma("unroll") for (unsigned _j = 0; _j < (unsigned)NV; ++_j) { dma16(_r, _v + _j * 256u, _so, vdst + (slot) * (unsigned)VSL + _j * (unsigned)SHM_V);        \
      dma16(_r, _v + _j * 256u + 128u, _so, vdst + (slot) * (unsigned)VSL + _j * (unsigned)SHM_V + 1024u); } } while (0)
  const unsigned k4v = (unsigned)((wv & 3) * 16 + (lane >> 4)), k4c = (unsigned)(((lane & 15) ^ (lane >> 4)) << 4), v4v = (unsigned)((wv & 3) * 16 + ((lane & 31) >> 2));
  const unsigned k4dst = (unsigned)(uintptr_t)K_lds + (unsigned)(wv & 3) * 4096u, v4dst = (unsigned)(uintptr_t)V_lds + (unsigned)(wv & 3) * 4096u;
#define DMA4_K(t, slot) do { const int _k0 = (t) * KVBLK; const bool _s1 = _k0 < n1; const u32x4 _r = RSRC(_s1 ? U.K1 : U.K2);                                 \
    const unsigned _ldb = (unsigned)(_s1 ? U.ld1 : U.ld2) * 2u, _so = (unsigned)(_s1 ? _k0 : _k0 - n1) * _ldb, _v = k4v * _ldb + k4c;    \
    _Pragma("unroll") for (unsigned _n = 0; _n < 4; ++_n) dma16(_r, _v ^ (_n << 6), _so + 4u * _n * _ldb, k4dst + (slot) * (unsigned)SHM_K + _n * 1024u); } while (0)
#define DMA4_V(t, slot) do { const int _k0 = (t) * KVBLK; const bool _s1 = _k0 < n1; const u32x4 _r = RSRC(_s1 ? U.V1 : U.V2);                                 \
    const unsigned _ldb = (unsigned)(_s1 ? U.ld1 : U.ld2) * 2u, _so = (unsigned)(_s1 ? _k0 : _k0 - n1) * _ldb, _v = v4v * _ldb + vcb;     \
    _Pragma("unroll") for (unsigned _j = 0; _j < (unsigned)NV; ++_j) _Pragma("unroll") for (unsigned _g = 0; _g < 2; ++_g) _Pragma("unroll") for (unsigned _n = 0; _n < 2; ++_n)  \
      dma16(_r, _v + _j * 256u + _n * 128u, _so + 8u * _g * _ldb, v4dst + (slot) * (unsigned)VSL + _j * (unsigned)SHM_V + _g * 2048u + _n * 1024u); } while (0)
  DMA_K(0, 0); DMA_V(0, 0); DMA_K(1, 1);
  {
    float x[8][8];
#pragma unroll
    for (int d0 = 0; d0 < 8; ++d0) { const u32x4 w = *reinterpret_cast<const u32x4*>(&qr[d0]);
#pragma unroll
      for (int e = 0; e < 4; ++e) { x[d0][2 * e] = __uint_as_float(w[e] << 16); x[d0][2 * e + 1] = __uint_as_float(w[e] & 0xffff0000u); } }
    if (U.qw) { float ss = 0.f;
#pragma unroll
      for (int d0 = 0; d0 < 8; ++d0)
#pragma unroll
        for (int e = 0; e < 8; ++e) ss += x[d0][e] * x[d0][e];
      { auto rr = __builtin_amdgcn_permlane32_swap(__float_as_uint(ss), __float_as_uint(ss), false, false); ss = __uint_as_float(rr[0]) + __uint_as_float(rr[1]); }
      const float rn = rsqrtf(ss * (1.0f / 128.0f) + 1e-6f);
#pragma unroll
      for (int d0 = 0; d0 < 8; ++d0) { const float4 w0 = *(const float4*)(U.qw + d0 * 16 + hi * 8), w1 = *(const float4*)(U.qw + d0 * 16 + hi * 8 + 4);
        x[d0][0] *= rn * w0.x; x[d0][1] *= rn * w0.y; x[d0][2] *= rn * w0.z; x[d0][3] *= rn * w0.w; x[d0][4] *= rn * w1.x; x[d0][5] *= rn * w1.y; x[d0][6] *= rn * w1.z; x[d0][7] *= rn * w1.w;
        if (d0 & 1) SBAR(); } }
    if (U.rope) { const int t = U.t0 + wid * QBLK + r32;
#pragma unroll
      for (int a = 0; a < 2; ++a) { const int pos = a ? (t & 63) : (t >> 6);
#pragma unroll
        for (int dd = 0; dd < 2; ++dd) { const int d0 = a * 4 + dd; const float* cp = U.rope + pos * 32 + dd * 16 + hi * 8;
          const float4 c0 = *(const float4*)cp, c1 = *(const float4*)(cp + 4), s0 = *(const float4*)(cp + 2048), s1 = *(const float4*)(cp + 2048 + 4);
          const float cs[8] = {c0.x, c0.y, c0.z, c0.w, c1.x, c1.y, c1.z, c1.w}, sn[8] = {s0.x, s0.y, s0.z, s0.w, s1.x, s1.y, s1.z, s1.w};
#pragma unroll
          for (int e = 0; e < 8; ++e) { const float x1 = x[d0][e], x2 = x[d0 + 2][e]; x[d0][e] = x1 * cs[e] - x2 * sn[e]; x[d0 + 2][e] = x2 * cs[e] + x1 * sn[e]; }
          SBAR(); } } }
    float sq = 0.f;
#pragma unroll
    for (int d0 = 0; d0 < 8; ++d0)
#pragma unroll
      for (int e = 0; e < 8; ++e) sq += x[d0][e] * x[d0][e];
    { auto rr = __builtin_amdgcn_permlane32_swap(__float_as_uint(sq), __float_as_uint(sq), false, false); sq = __uint_as_float(rr[0]) + __uint_as_float(rr[1]); }
    float km = 0.f;
    for (int j = lane; j < (int)gridDim.x; j += 64) km = fmaxf(km, U.kp[(size_t)j * KP_STRIDE]);
    { int ll = lane; asm volatile("" : "+v"(ll));
#pragma unroll
      for (int o2 = 32; o2 >= 1; o2 >>= 1) km = fmaxf(km, shfl_xor_at(km, o2, ll)); }
    km = fmaxf(km, U.kcm);
    mnC = -(sqrtf(sq) * km * 1.02f) * (SCALE * 1.4426950408889634f);
#pragma unroll
    for (int d0 = 0; d0 < 8; ++d0)
#pragma unroll
      for (int e = 0; e < 8; ++e) x[d0][e] *= (SCALE * 1.4426950408889634f);
#pragma unroll
    for (int d0 = 0; d0 < 8; ++d0) { u32x4 w = {cvt_pk_rn(x[d0][0], x[d0][1]), cvt_pk_rn(x[d0][2], x[d0][3]), cvt_pk_rn(x[d0][4], x[d0][5]), cvt_pk_rn(x[d0][6], x[d0][7])}; qr[d0] = *reinterpret_cast<bf16x8*>(&w); }
  }
  f32x16 C0, C1; const int NT = (U.n1 + U.n2) / KVBLK;
  u32x4 fw[FW]; u32x4 pw[4];
  lds_cptr kp[8]; const lds_cptr vp = (lds_cptr)(unsigned)vb0;
  { const unsigned s = (unsigned)r32 & 15u, kb = (unsigned)(uintptr_t)K_lds + (unsigned)r32 * 256u;
#pragma unroll
    for (int j = 0; j < 8; ++j) kp[j] = (lds_cptr)(kb + ((((unsigned)j * 2u + (unsigned)hi) ^ s) << 4)); }
  const bool shift = __any(mnC < -100.f);
  const int role = wv >> 2;
#define VS_TAIL() do { float sacc = 0.f;                                                                                                          \
    _Pragma("unroll") for (int r = 0; r < 16; ++r) { C0[r] = __builtin_amdgcn_exp2f(C0[r]); sacc += C0[r]; }                                  \
    _Pragma("unroll") for (int r = 0; r < 16; ++r) { C1[r] = __builtin_amdgcn_exp2f(C1[r]); sacc += C1[r]; }                                  \
    l_reg += sacc; PIN(l_reg);                                            \
    _Pragma("unroll") for (int m = 0; m < 4; ++m) _Pragma("unroll") for (int i = 0; i < 4; ++i) { const int e = 8 * (m & 1) + 2 * i;          \
        pw[m][i] = (m >> 1) ? cvt_pk_rn(C1[e], C1[e + 1]) : cvt_pk_rn(C0[e], C0[e + 1]); } } while (0)
#define VSEG(t, FIRST) do { const int _s = (t) + 1;                                                                                           \
    if (role) { if (_s + 1 < NT) { if (_s & 1) DMA4_K(_s + 1, 0); else DMA4_K(_s + 1, 1); }                                                   \
                if (_s < NT) { if (_s & 1) DMA4_V(_s, 1); else DMA4_V(_s, 0); } }                                                             \
    if (FIRST) {                         \
      if (shift) { float pmax = C0[0];                        \
        _Pragma("unroll") for (int r = 1; r < 16; ++r) pmax = fmaxf(pmax, C0[r]);                                                             \
        _Pragma("unroll") for (int r = 0; r < 16; ++r) pmax = fmaxf(pmax, C1[r]);                                                             \
        { auto rr = __builtin_amdgcn_permlane32_swap(__float_as_uint(pmax), __float_as_uint(pmax), false, false); pmax = fmaxf(__uint_as_float(rr[0]), __uint_as_float(rr[1])); } \
        mnC = -fminf(-mnC, pmax + 57.7f); } else mnC = 0.f; }                                                                                 \
      \
    if (shift) { _Pragma("unroll") for (int r = 0; r < 16; ++r) { C0[r] += mnC; C1[r] += mnC; } VS_TAIL(); } else { VS_TAIL(); }                \
    } while (0)
  DSYNC();
  if (role) DSYNC();
  MSeg<NV, 0, 16, 16 * NV, 0, 0>::run(o, pw, C0, C1, qr, fw, vp, kp);
  DSYNC(); VSEG(0, true); BSYNC();
  for (int t = 1; t + 1 < NT; t += 2) {
    MSeg<NV, 0, 16 * NV + 16, 0, (int)SHM_K, 0>::run(o, pw, C0, C1, qr, fw, vp, kp);
    DSYNC(); VSEG(t, false); BSYNC();
    MSeg<NV, 0, 16 * NV + 16, 0, 0, (int)VSL>::run(o, pw, C0, C1, qr, fw, vp, kp);
    DSYNC(); VSEG(t + 1, false); BSYNC();
  }
  MSeg<NV, 0, 16 * NV + 16, 0, (int)SHM_K, 0>::run(o, pw, C0, C1, qr, fw, vp, kp);
  DSYNC(); VSEG(NT - 1, false); BSYNC();
  MSeg<NV, 0, 16 * NV, 0, 0, (int)VSL>::run(o, pw, C0, C1, qr, fw, vp, kp);
  if (!role) DSYNC();
#undef VSEG
#undef VS_TAIL
  { auto rr = __builtin_amdgcn_permlane32_swap(__float_as_uint(l_reg), __float_as_uint(l_reg), false, false); l_reg = __uint_as_float(rr[0]) + __uint_as_float(rr[1]); }
  if (hi == 0) li_l[r32] = l_reg; asm volatile("s_waitcnt lgkmcnt(0)" ::: "memory");
  {
    int r32e = r32, hie = hi, lne = lane; asm volatile("" : "+v"(r32e), "+v"(hie), "+v"(lne));
    char* ot = lds + SHM_ATTN + wid * 4608;
    const int erow = lne >> 1, esub = (lne & 1) * 32;
#pragma unroll
    for (int h = 0; h < 2 * NV; ++h) {
#pragma unroll
      for (int r = 0; r < 16; ++r) { const int orow = crow(r, hie); const float rl = __builtin_amdgcn_rcpf(li_l[orow]);
#pragma unroll
        for (int dd = 0; dd < 2; ++dd) *(bf16_t*)(ot + orow * 144 + (dd * 32 + r32e) * 2) = f2bf(o[2 * h + dd][r] * rl); }
      asm volatile("s_waitcnt lgkmcnt(0)" ::: "memory");
      bf16_t* Op = U.O + (long)(wid * QBLK + erow) * U.ldo + h * 64 + esub;
      if (U.G) {
        const bf16_t* Gp = U.G + (long)(wid * QBLK + erow) * U.ldg + h * 64 + esub;
        u32x4 gv[4];
#pragma unroll
        for (int c = 0; c < 4; ++c) gv[c] = *reinterpret_cast<const u32x4*>(Gp + c * 8);
#pragma unroll
        for (int c = 0; c < 4; ++c) { const u32x4 ov = *reinterpret_cast<const u32x4*>(ot + erow * 144 + esub * 2 + c * 16); u32x4 w;
#pragma unroll
          for (int e = 0; e < 4; ++e) { const float g0 = silu_f(__uint_as_float(gv[c][e] << 16)), g1 = silu_f(__uint_as_float(gv[c][e] & 0xffff0000u));
            w[e] = cvt_pk_rn(__uint_as_float(ov[e] << 16) * g0, __uint_as_float(ov[e] & 0xffff0000u) * g1); }
          *reinterpret_cast<u32x4*>(Op + c * 8) = w; }
      } else {
#pragma unroll
        for (int c = 0; c < 4; ++c) *reinterpret_cast<u32x4*>(Op + c * 8) = *reinterpret_cast<const u32x4*>(ot + erow * 144 + esub * 2 + c * 16);
      }
      asm volatile("s_waitcnt lgkmcnt(0)" ::: "memory");
    }
  }
#undef DSYNC
#undef BSYNC
#undef DMA4_K
#undef DMA4_V
#undef RSRC
#undef DMA_K
#undef DMA_V
}
#undef KSWZ
#undef PIN
#undef MFMA32
#undef SBAR
}

constexpr int NTHR = 512, NWAVE = 8;

__device__ __forceinline__ bf16_t* wsb(const Params& p, size_t off) { return (bf16_t*)(p.ws + off); }
__device__ __forceinline__ float* wsf(const Params& p, size_t off) { return (float*)(p.ws + off); }
__device__ __forceinline__ const float* x_row(const Params& p, int l, int row) {
    if (l == 0) return row < M_CTX ? inp(IN_X_PROMPT) + (size_t)row * DM : inp(IN_X_SAMPLE) + (size_t)(row - M_CTX) * DM;
    return p.out + OUT_Y + (size_t)row * DM;
}

__device__ __forceinline__ void phase_mod(const Params& p, unsigned char* lds, int wv) {
    float* sl = (float*)lds;
    float* red = (float*)(lds + 9 * 2048 * 4);
    const int tid = opaque_tid(wv), wid = tid >> 6, lane = tid & 63;
    float* mod = wsf(p, WS_MOD);
    for (int u = blockIdx.x; u < 2 * 192; u += gridDim.x) {
        const int l = u / 192, j0 = (u % 192) * 64;
        const float* W = inp(IN_W_MOD) + (size_t)l * DM * MODW + j0 + lane;
        float acc[9];
#pragma unroll
        for (int ci = 0; ci < 9; ++ci) acc[ci] = 0.f;
        for (int kh = 0; kh < 2; ++kh) {
            __syncthreads();
            for (int i = tid; i < 9 * 2048; i += NTHR) { const int ci = i >> 11, k = kh * 2048 + (i & 2047);
                const float cv = (ci == 0) ? inp(IN_C_CTX)[k] : inp(IN_C)[(size_t)(ci - 1) * DM + k]; sl[i] = silu_f(cv); }
            __syncthreads();
            const int kb = wid * 256;
#pragma unroll 32
            for (int kk = 0; kk < 256; ++kk) {
                const float w = W[(size_t)(kh * 2048 + kb + kk) * MODW];
#pragma unroll
                for (int ci = 0; ci < 9; ++ci) acc[ci] += sl[ci * 2048 + kb + kk] * w;
            }
        }
#pragma unroll
        for (int ci = 0; ci < 9; ++ci) red[(wid * 9 + ci) * 64 + lane] = acc[ci];
        __syncthreads();
        for (int i = tid; i < 9 * 64; i += NTHR) { const int ci = i >> 6, col = i & 63; float s = 0.f;
#pragma unroll
            for (int w = 0; w < 8; ++w) s += red[(w * 9 + ci) * 64 + col];
            mod[((size_t)l * 9 + ci) * MODW + j0 + col] = s + inp(IN_B_MOD)[(size_t)l * MODW + j0 + col]; }
        __syncthreads();
    }
}

__device__ __forceinline__ int win_orig_col(int np) { return np < 4096 ? np : (np < 13312 ? np + 32 : (np < 13344 ? np - 13312 + 4096 : -1)); }
constexpr int CVT_NT_IN = (NPAD / 64) * 64, CVT_NT_OUT = 64 * 64;
__device__ __forceinline__ void cvt_weight_tile(const Params& p, int task, int wl_in, int wl_out, unsigned char* wt, int lane) {
    const float* src; bf16_t* dst; int ldsrc, nt, kt; bool isin;
    if (task < CVT_NT_IN) { nt = task % (NPAD / 64); kt = task / (NPAD / 64); src = inp(IN_W_IN) + (size_t)wl_in * DM * IN_COLS; ldsrc = IN_COLS; dst = wsb(p, WS_WINT) + (size_t)wl_in * NPAD * DM; isin = true; }
    else { const int r = task - CVT_NT_IN; nt = r & 63; kt = r >> 6; src = inp(IN_W_OUT) + (size_t)wl_out * DM * DM; ldsrc = DM; dst = wsb(p, WS_WOUTT) + (size_t)wl_out * DM * DM; isin = false; }
    const int n = nt * 64 + lane, k0 = kt * 64, oc = isin ? win_orig_col(n) : n;
    float v[64];
    const float* sp = src + (size_t)k0 * ldsrc + (oc >= 0 ? oc : 0);
#pragma unroll
    for (int k = 0; k < 64; ++k) v[k] = sp[(size_t)k * ldsrc];
    if (oc < 0) {
#pragma unroll
        for (int k = 0; k < 64; ++k) v[k] = 0.f; }
#pragma unroll
    for (int hf = 0; hf < 2; ++hf) {
        if ((lane >> 5) == hf) {
#pragma unroll
            for (int k8 = 0; k8 < 8; ++k8) *(uint4*)(wt + (lane & 31) * 144 + k8 * 16) = make_uint4(cvt_pk_rn(v[k8 * 8], v[k8 * 8 + 1]), cvt_pk_rn(v[k8 * 8 + 2], v[k8 * 8 + 3]), cvt_pk_rn(v[k8 * 8 + 4], v[k8 * 8 + 5]), cvt_pk_rn(v[k8 * 8 + 6], v[k8 * 8 + 7])); }
        asm volatile("s_waitcnt lgkmcnt(0)" ::: "memory");
#pragma unroll
        for (int it = 0; it < 4; ++it) { const int rr = it * 8 + (lane >> 3), ch = lane & 7;
            *(uint4*)(dst + (size_t)(nt * 64 + hf * 32 + rr) * DM + k0 + ch * 8) = *(const uint4*)(wt + rr * 144 + ch * 16); }
        asm volatile("s_waitcnt lgkmcnt(0)" ::: "memory");
    }
}
__device__ __forceinline__ void phase_cvt(const Params& p, unsigned char* lds, int wv) {
    const int tid = opaque_tid(wv), wid = tid >> 6, lane = tid & 63;
    for (int u = blockIdx.x * NWAVE + wid; u < 2 * CVT_NT_IN; u += gridDim.x * NWAVE) cvt_weight_tile(p, u % CVT_NT_IN, u / CVT_NT_IN, 0, lds + wid * 4608, lane);
    {
        const size_t n_g = (size_t)8 * 2 * 256 * 512, n_d = (size_t)8 * 2 * 256 * 1024;
        const size_t tot4 = (2 * n_g + 2 * n_d) / 4;
        for (size_t i = (size_t)blockIdx.x * NTHR + tid; i < tot4; i += (size_t)gridDim.x * NTHR) {
            size_t e = i * 4; const float* s; bf16_t* d;
            if (e < n_g) { s = inp(IN_CACHE_GQA_K) + e; d = wsb(p, WS_CKG) + e; }
            else if (e < 2 * n_g) { e -= n_g; s = inp(IN_CACHE_GQA_V) + e; d = wsb(p, WS_CVG) + e; }
            else if (e < 2 * n_g + n_d) { e -= 2 * n_g; s = inp(IN_CACHE_DIFF_K) + e; d = wsb(p, WS_CKD) + e; }
            else { e -= 2 * n_g + n_d; s = inp(IN_CACHE_DIFF_V) + e; d = wsb(p, WS_CVD) + e; }
            const float4 v = *(const float4*)s; uint2 w; w.x = pk2bf(v.x, v.y); w.y = pk2bf(v.z, v.w); *(uint2*)d = w;
        }
    }
    { const int gw = blockIdx.x * NWAVE + wid;
      if (gw < 48) { const int l16 = lane & 15, sub = lane >> 4; const bool isg = gw < 16; const int bl = isg ? gw : (gw - 16) >> 1, grp = isg ? 0 : (gw - 16) & 1;
          const float* base = (isg ? inp(IN_CACHE_GQA_K) + (size_t)bl * 256 * 512 : inp(IN_CACHE_DIFF_K) + (size_t)bl * 256 * 1024 + grp * 512) + sub * 128 + l16 * 8;
          const int ld = isg ? 512 : 1024; float km = 0.f;
#pragma unroll 4
          for (int t = 0; t < 256; ++t) { const float4 a = *(const float4*)(base + (size_t)t * ld), c = *(const float4*)(base + (size_t)t * ld + 4);
              float s2 = a.x * a.x + a.y * a.y + a.z * a.z + a.w * a.w + c.x * c.x + c.y * c.y + c.z * c.z + c.w * c.w;
              s2 += __shfl_xor(s2, 1); s2 += __shfl_xor(s2, 2); s2 += __shfl_xor(s2, 4); s2 += __shfl_xor(s2, 8); km = fmaxf(km, s2); }
          if (l16 == 0) { const int b = bl >> 1, ll = bl & 1; float* ck = wsf(p, WS_CKM);
              if (isg) ck[(ll * 8 + b) * 4 + sub] = sqrtf(km); else ck[64 + (ll * 8 + b) * 8 + grp * 4 + sub] = sqrtf(km); } } }
    if (blockIdx.x == 0) {
        float* rope = wsf(p, WS_ROPE);
        for (int i = tid; i < 64 * 32; i += NTHR) { const int pos = i >> 5, fi = i & 31;
            const float inv = exp2f(-(float)(2 * fi) * (13.287712379549449f / 64.0f)); const float ang = (float)pos * inv;
            rope[i] = __cosf(ang); rope[2048 + i] = __sinf(ang); }
    }
}

__device__ __forceinline__ void phase_prenorm(const Params& p, int l, int wv) {
    const int tid = opaque_tid(wv), wid = tid >> 6, lane = tid & 63;
    const float* modl = wsf(p, WS_MOD) + (size_t)l * 9 * MODW; const float* pw = inp(IN_PRE_W) + (size_t)l * DM;
    bf16_t* H = wsb(p, WS_H);
    for (int row = blockIdx.x * NWAVE + wid; row < M_ALL; row += gridDim.x * NWAVE) {
        const float* x = x_row(p, l, row); const int ci = cond_of_row(row);
        float4 v[16]; float ss = 0.f;
#pragma unroll
        for (int i = 0; i < 16; ++i) { v[i] = *(const float4*)(x + (i * 64 + lane) * 4); ss += v[i].x * v[i].x + v[i].y * v[i].y + v[i].z * v[i].z + v[i].w * v[i].w; }
        ss = wave_sum(ss); const float rstd = rsqrtf(ss * (1.0f / DM) + NORM_EPS);
        const float* sh = modl + (size_t)ci * MODW; const float* sc = sh + DM;
#pragma unroll
        for (int i = 0; i < 16; ++i) { const int col = (i * 64 + lane) * 4;
            const float4 w = *(const float4*)(pw + col), s1 = *(const float4*)(sc + col), s0 = *(const float4*)(sh + col);
            uint2 o; o.x = pk2bf(v[i].x * rstd * w.x * (1.f + s1.x) + s0.x, v[i].y * rstd * w.y * (1.f + s1.y) + s0.y);
            o.y = pk2bf(v[i].z * rstd * w.z * (1.f + s1.z) + s0.z, v[i].w * rstd * w.w * (1.f + s1.w) + s0.w);
            *(uint2*)(H + (size_t)row * DM + col) = o; }
    }
}

__device__ __forceinline__ void phase_gemm1(const Params& p, int l, unsigned char* lds, int wv) {
    pg8::Gemm g; g.A = wsb(p, WS_H); g.Bt = wsb(p, WS_WINT) + (size_t)l * NPAD * DM; g.M = M_ALL; g.N = NPAD; g.K = DM;
    pg8::StaticOrder S; S.init(g.M, g.N, (int)gridDim.x, (int)blockIdx.x, 1);
    pg8::EpiZ E; E.ZA = wsb(p, WS_ZA); E.ZB = wsb(p, WS_ZB); E.ZC = wsb(p, WS_ZC); E.AB = wsf(p, WS_AB);
    pg8::gemm_phase<pg8::EpiZ, pg8::StaticOrder>((PG8_LAS unsigned char*)lds, g, S, E, wv);
}

__device__ __forceinline__ void phase_attnprep(const Params& p, int l, unsigned char* lds, int wv) {
    const int tid = opaque_tid(wv), wid = tid >> 6, lane = tid & 63, l16 = lane & 15, sub = lane >> 4, d0 = 8 * l16;
    unsigned* kt = (unsigned*)lds;
    for (int i = tid; i < KP_STRIDE; i += NTHR) kt[i] = 0u;
    __syncthreads();
    const float* rope = wsf(p, WS_ROPE);
    float qw[8], kw[8];
    { const float* qp = inp(IN_Q_NORM_W) + (size_t)l * 128 + d0; const float* kp = inp(IN_K_NORM_W) + (size_t)l * 128 + d0;
#pragma unroll
      for (int e = 0; e < 8; ++e) { qw[e] = qp[e]; kw[e] = kp[e]; } }
    bf16_t* ZB = wsb(p, WS_ZB); bf16_t* ZC = wsb(p, WS_ZC);
    const bool lo = (l16 & 4) == 0; const int jr = 8 * (l16 & 3);
    for (int row = blockIdx.x * NWAVE + wid; row < M_ALL; row += gridDim.x * NWAVE) {
        const bool ctx = row < M_CTX;
        bf16_t* zb = ZB + (size_t)row * ZB_W + sub * 128 + d0; bf16_t* zc = ZC + (size_t)row * ZC_W + sub * 128 + d0;
        uint4 v[12];
#pragma unroll
        for (int g = 0; g < 12; ++g) {
            const bool act = ctx ? (g == 4 || g == 5 || g >= 8) : (g == 4 || g == 8 || g == 9);
            bf16_t* ptr = g < 4 ? zb + g * 512 : (g == 4 ? zb + 2048 : (g == 5 ? zb + 2560 : zc + (g - 6) * 512));
            v[g] = act ? *(const uint4*)ptr : make_uint4(0u, 0u, 0u, 0u);
        }
        float cs[8], sn[8];
        if (!ctx) { const int tt = (row - M_CTX) & 4095; const int pos = (l16 & 8) ? (tt & 63) : (tt >> 6);
            const float4 c0 = *(const float4*)(rope + pos * 32 + jr), c1 = *(const float4*)(rope + pos * 32 + jr + 4), s0 = *(const float4*)(rope + 2048 + pos * 32 + jr), s1 = *(const float4*)(rope + 2048 + pos * 32 + jr + 4);
            cs[0] = c0.x; cs[1] = c0.y; cs[2] = c0.z; cs[3] = c0.w; cs[4] = c1.x; cs[5] = c1.y; cs[6] = c1.z; cs[7] = c1.w;
            sn[0] = s0.x; sn[1] = s0.y; sn[2] = s0.z; sn[3] = s0.w; sn[4] = s1.x; sn[5] = s1.y; sn[6] = s1.z; sn[7] = s1.w; }
        else {
#pragma unroll
            for (int e = 0; e < 8; ++e) { cs[e] = 1.f; sn[e] = 0.f; } }
        const int b = row >> 8, tt = row & 255; const size_t tb = ((size_t)(b * 2 + l) * 256 + tt);
#pragma unroll
        for (int g = 0; g < 12; ++g) {
            const bool act = ctx ? (g == 4 || g == 5 || g >= 8) : (g == 4 || g == 8 || g == 9);
            if (!act) continue;
            bf16_t* ptr = g < 4 ? zb + g * 512 : (g == 4 ? zb + 2048 : (g == 5 ? zb + 2560 : zc + (g - 6) * 512));
            float x[8]; const unsigned w[4] = {v[g].x, v[g].y, v[g].z, v[g].w};
#pragma unroll
            for (int e = 0; e < 4; ++e) { x[2 * e] = __uint_as_float(w[e] << 16); x[2 * e + 1] = __uint_as_float(w[e] & 0xffff0000u); }
            if (g <= 4) { float ss = 0.f;
#pragma unroll
                for (int e = 0; e < 8; ++e) ss += x[e] * x[e];
                ss += __shfl_xor(ss, 1); ss += __shfl_xor(ss, 2); ss += __shfl_xor(ss, 4); ss += __shfl_xor(ss, 8);
                const float r = rsqrtf(ss * (1.0f / 128.0f) + NORM_EPS);
#pragma unroll
                for (int e = 0; e < 8; ++e) x[e] *= r * (g < 4 ? qw[e] : kw[e]); }
            if (g == 4 || g == 8 || g == 9) {
                float s2 = 0.f;
#pragma unroll
                for (int e = 0; e < 8; ++e) s2 += x[e] * x[e];
                s2 += __shfl_xor(s2, 1); s2 += __shfl_xor(s2, 2); s2 += __shfl_xor(s2, 4); s2 += __shfl_xor(s2, 8);
                if (l16 == 0) { const int seq = ctx ? (row >> 8) : 16 + ((row - M_CTX) >> 12), slot = g == 4 ? sub : 4 + (g - 8) * 4 + sub;
                    atomicMax(&kt[seq * 12 + slot], __float_as_uint(sqrtf(s2))); } }
            if (ctx) {
                if (g >= 4) { float* o = g == 4 ? p.out + OUT_GK + tb * 512 : (g == 5 ? p.out + OUT_GV + tb * 512 : (g < 10 ? p.out + OUT_DK + tb * 1024 + (g - 8) * 512 : p.out + OUT_DV + tb * 1024 + (g - 10) * 512));
                    o += sub * 128 + d0;
                    *(float4*)o = make_float4(x[0], x[1], x[2], x[3]); *(float4*)(o + 4) = make_float4(x[4], x[5], x[6], x[7]); }
                if (g <= 4) { uint4 ov; ov.x = cvt_pk_rn(x[0], x[1]); ov.y = cvt_pk_rn(x[2], x[3]); ov.z = cvt_pk_rn(x[4], x[5]); ov.w = cvt_pk_rn(x[6], x[7]); *(uint4*)ptr = ov; }
            } else {
                float y[8];
#pragma unroll
                for (int e = 0; e < 8; ++e) { const float pr = __shfl_xor(x[e], 4); y[e] = lo ? x[e] * cs[e] - pr * sn[e] : x[e] * cs[e] + pr * sn[e]; }
                uint4 ov; ov.x = cvt_pk_rn(y[0], y[1]); ov.y = cvt_pk_rn(y[2], y[3]); ov.z = cvt_pk_rn(y[4], y[5]); ov.w = cvt_pk_rn(y[6], y[7]); *(uint4*)ptr = ov;
            }
        }
    }
    __syncthreads();
    { float* kp = wsf(p, WS_KP) + (size_t)blockIdx.x * KP_STRIDE; for (int i = tid; i < KP_STRIDE; i += NTHR) kp[i] = __uint_as_float(kt[i]); }
}

__device__ __forceinline__ void phase_attn(const Params& p, int l, unsigned char* lds, int wv) {
    bf16_t* ZB = wsb(p, WS_ZB); bf16_t* ZC = wsb(p, WS_ZC); bf16_t* MIX = wsb(p, WS_H); bf16_t* DT = wsb(p, WS_DTMP);
    const float* qnw = inp(IN_Q_NORM_W) + (size_t)l * 128; const float* ropet = wsf(p, WS_ROPE);
    const bf16_t* CKG = wsb(p, WS_CKG); const bf16_t* CVG = wsb(p, WS_CVG); const bf16_t* CKD = wsb(p, WS_CKD); const bf16_t* CVD = wsb(p, WS_CVD);
    const float* KP = wsf(p, WS_KP); const float* CKM = wsf(p, WS_CKM);
    const int G = gridDim.x, cswz = (G & 7) == 0 ? (int)(blockIdx.x & 7) * (G >> 3) + (int)(blockIdx.x >> 3) : (int)blockIdx.x;
    const int bg_ntask = CVT_NT_OUT, bg_calls = 2880 / G, bg_nslot = bg_calls * G * 4; int bg_call = 0;
    for (int w = cswz; w < 2880; w += G) {
        const bool dgroup = (w >= 2048 && w < 2560) || w >= 2816;
        const int nsub = dgroup ? 2 : 1;
        size_t r0c = 0; int hc = 0;
        for (int sub = 0; sub < nsub; ++sub) {
            att::Unit U;
            if (w < 2048) {
                const int b = w >> 8, rem = w & 255, kvh = rem >> 6, qb = (rem & 63) >> 2, g = rem & 3, hq = kvh * 4 + g;
                const size_t s0 = (size_t)M_CTX + (size_t)b * 4096, r0 = s0 + (size_t)qb * 256;
                U.Q = ZB + r0 * ZB_W + hq * 128; U.ldq = ZB_W; U.qw = qnw; U.rope = ropet; U.t0 = qb * 256;
                U.K1 = ZB + s0 * ZB_W + 2048 + kvh * 128; U.V1 = U.K1 + 512; U.ld1 = ZB_W; U.n1 = 4096;
                const size_t cb = (size_t)(b * 2 + l) * 256 * 512 + kvh * 128;
                U.K2 = CKG + cb; U.V2 = CVG + cb; U.ld2 = 512; U.n2 = 256;
                U.O = MIX + r0 * DM + 1024 + hq * 128; U.ldo = DM; U.G = ZB + r0 * ZB_W + 3072 + hq * 128; U.ldg = ZB_W;
                U.kp = KP + (16 + b) * 12 + kvh; U.kcm = CKM[(l * 8 + b) * 4 + kvh];
            } else if (w < 2560) {
                const int v = w - 2048, b = v >> 6, h = (v >> 4) & 3, qb = v & 15, i = sub;
                const size_t s0 = (size_t)M_CTX + (size_t)b * 4096, r0 = s0 + (size_t)qb * 256; r0c = r0; hc = h;
                U.Q = ZC + r0 * ZC_W + h * 256 + i * 128; U.ldq = ZC_W; U.qw = nullptr; U.rope = ropet; U.t0 = qb * 256;
                U.K1 = ZC + s0 * ZC_W + 1024 + h * 256 + i * 128; U.V1 = ZC + s0 * ZC_W + 2048 + h * 256; U.ld1 = ZC_W; U.n1 = 4096;
                const size_t cb = (size_t)(b * 2 + l) * 256 * 1024 + h * 256;
                U.K2 = CKD + cb + i * 128; U.V2 = CVD + cb; U.ld2 = 1024; U.n2 = 256;
                U.O = DT + (size_t)i * M_ALL * 1024 + r0 * 1024 + h * 256; U.ldo = 1024; U.G = nullptr; U.ldg = 0;
                U.kp = KP + (16 + b) * 12 + 4 + h * 2 + i; U.kcm = CKM[64 + (l * 8 + b) * 8 + h * 2 + i];
            } else if (w < 2816) {
                const int v = w - 2560, b = v >> 4, hq = v & 15; const size_t r0 = (size_t)b * 256;
                U.Q = ZB + r0 * ZB_W + hq * 128; U.ldq = ZB_W; U.qw = qnw; U.rope = nullptr; U.t0 = 0;
                U.K1 = ZB + r0 * ZB_W + 2048 + (hq >> 2) * 128; U.V1 = U.K1 + 512; U.ld1 = ZB_W; U.n1 = 256;
                U.K2 = U.K1; U.V2 = U.V1; U.ld2 = ZB_W; U.n2 = 0;
                U.O = MIX + r0 * DM + 1024 + hq * 128; U.ldo = DM; U.G = ZB + r0 * ZB_W + 3072 + hq * 128; U.ldg = ZB_W;
                U.kp = KP + b * 12 + (hq >> 2); U.kcm = 0.f;
            } else {
                const int v = w - 2816, b = v >> 2, h = v & 3, i = sub; const size_t r0 = (size_t)b * 256; r0c = r0; hc = h;
                U.Q = ZC + r0 * ZC_W + h * 256 + i * 128; U.ldq = ZC_W; U.qw = nullptr; U.rope = nullptr; U.t0 = 0;
                U.K1 = ZC + r0 * ZC_W + 1024 + h * 256 + i * 128; U.V1 = ZC + r0 * ZC_W + 2048 + h * 256; U.ld1 = ZC_W; U.n1 = 256;
                U.K2 = U.K1; U.V2 = U.V1; U.ld2 = ZC_W; U.n2 = 0;
                U.O = DT + (size_t)i * M_ALL * 1024 + r0 * 1024 + h * 256; U.ldo = 1024; U.G = nullptr; U.ldg = 0;
                U.kp = KP + b * 12 + 4 + h * 2 + i; U.kcm = 0.f;
            }
            if (dgroup) att::attn_unit<2>(U, (char*)lds, wv); else att::attn_unit<1>(U, (char*)lds, wv);
            if (bg_call < bg_calls) {
                if (wv < 4) { const int lane_bg = opaque_tid(wv) & 63;
                    for (int task = (bg_call * G + (int)blockIdx.x) * 4 + wv; task < bg_ntask; task += bg_nslot)
                        cvt_weight_tile(p, task + CVT_NT_IN, 0, l, lds + att::SHM_ATTN + wv * 4608, lane_bg); }
                ++bg_call; }
        }
        if (dgroup) {
            asm volatile("s_waitcnt vmcnt(0)" ::: "memory");
            const int tid = opaque_tid(wv), wid = tid >> 6, lane = tid & 63, l16 = lane & 15, rsub = lane >> 4;
            int ll = l; asm volatile("" : "+s"(ll));
            const float lam_init = ll == 0 ? 0.2f : (0.8f - 0.6f * 0.74081822068171788f);
            const float* lp = inp(IN_DIFF_LAMBDA) + (size_t)ll * 4 * 128;
            float s1 = lp[lane] * lp[128 + lane] + lp[64 + lane] * lp[128 + 64 + lane], s2 = lp[256 + lane] * lp[384 + lane] + lp[256 + 64 + lane] * lp[384 + 64 + lane];
#pragma unroll
            for (int o2 = 32; o2 >= 1; o2 >>= 1) { s1 += shfl_xor_at(s1, o2, lane); s2 += shfl_xor_at(s2, o2, lane); }
            const float lam = expf(s1) - expf(s2) + lam_init;
            float nw[16];
            { const float* np = inp(IN_DIFF_NORM_W) + (size_t)ll * 256 + l16 * 16;
#pragma unroll
              for (int e = 0; e < 16; ++e) nw[e] = np[e]; }
            const int c = hc * 256 + l16 * 16;
            for (int it = 0; it < 8; ++it) { const size_t row = r0c + wid * 32 + it * 4 + rsub;
                const bf16_t* a0p = DT + row * 1024 + c; const bf16_t* a1p = a0p + (size_t)M_ALL * 1024; const bf16_t* gp = ZC + row * ZC_W + 3072 + c;
                const uint4 a0a = *(const uint4*)a0p, a0b = *(const uint4*)(a0p + 8), a1a = *(const uint4*)a1p, a1b = *(const uint4*)(a1p + 8), ga = *(const uint4*)gp, gb = *(const uint4*)(gp + 8);
                const unsigned w0[8] = {a0a.x, a0a.y, a0a.z, a0a.w, a0b.x, a0b.y, a0b.z, a0b.w}, w1[8] = {a1a.x, a1a.y, a1a.z, a1a.w, a1b.x, a1b.y, a1b.z, a1b.w}, wg[8] = {ga.x, ga.y, ga.z, ga.w, gb.x, gb.y, gb.z, gb.w};
                float o[16]; float ss = 0.f;
#pragma unroll
                for (int e = 0; e < 8; ++e) { o[2 * e] = __uint_as_float(w0[e] << 16) - lam * __uint_as_float(w1[e] << 16); o[2 * e + 1] = __uint_as_float(w0[e] & 0xffff0000u) - lam * __uint_as_float(w1[e] & 0xffff0000u);
                    ss += o[2 * e] * o[2 * e] + o[2 * e + 1] * o[2 * e + 1]; }
                ss += shfl_xor_at(ss, 1, lane); ss += shfl_xor_at(ss, 2, lane); ss += shfl_xor_at(ss, 4, lane); ss += shfl_xor_at(ss, 8, lane);
                const float r = rsqrtf(ss * (1.0f / 256.0f) + NORM_EPS) * (1.0f - lam_init);
                unsigned ov[8];
#pragma unroll
                for (int e = 0; e < 8; ++e) ov[e] = cvt_pk_rn(o[2 * e] * r * nw[2 * e] * silu_f(__uint_as_float(wg[e] << 16)), o[2 * e + 1] * r * nw[2 * e + 1] * silu_f(__uint_as_float(wg[e] & 0xffff0000u)));
                bf16_t* op = MIX + row * DM + 3072 + c;
                *(uint4*)op = make_uint4(ov[0], ov[1], ov[2], ov[3]); *(uint4*)(op + 8) = make_uint4(ov[4], ov[5], ov[6], ov[7]); }
        }
    }
}

__device__ __forceinline__ void phase_dncomb(const Params& p, int l, int wv) {
    const int tid = opaque_tid(wv), wid = tid >> 6, lane = tid & 63, l16 = lane & 15, sub = lane >> 4;
    const bf16_t* DNO = wsb(p, WS_DNO); const bf16_t* ZA = wsb(p, WS_ZA); bf16_t* MIX = wsb(p, WS_H);
    float nw[8];
    { const float* np = inp(IN_DN_NORM_W) + (size_t)l * 128 + l16 * 8;
#pragma unroll
      for (int e = 0; e < 8; ++e) nw[e] = np[e]; }
    for (int row = blockIdx.x * NWAVE + wid; row < M_ALL; row += gridDim.x * NWAVE) {
        uint4 a[2], b[2]; uint4 g[2];
#pragma unroll
        for (int gi = 0; gi < 2; ++gi) { const int c = (gi * 4 + sub) * 128 + l16 * 8;
            a[gi] = *(const uint4*)(DNO + (size_t)row * 1024 + c); b[gi] = *(const uint4*)(DNO + ((size_t)M_ALL + row) * 1024 + c);
            g[gi] = *(const uint4*)(ZA + (size_t)row * ZA_W + 3072 + c); }
#pragma unroll
        for (int gi = 0; gi < 2; ++gi) { const int c = (gi * 4 + sub) * 128 + l16 * 8;
            const unsigned wa[4] = {a[gi].x, a[gi].y, a[gi].z, a[gi].w}, wb[4] = {b[gi].x, b[gi].y, b[gi].z, b[gi].w}; float x[8];
#pragma unroll
            for (int e = 0; e < 4; ++e) { x[2 * e] = __uint_as_float(wa[e] << 16) + __uint_as_float(wb[e] << 16); x[2 * e + 1] = __uint_as_float(wa[e] & 0xffff0000u) + __uint_as_float(wb[e] & 0xffff0000u); }
            float ss = 0.f;
#pragma unroll
            for (int e = 0; e < 8; ++e) ss += x[e] * x[e];
            ss += __shfl_xor(ss, 1); ss += __shfl_xor(ss, 2); ss += __shfl_xor(ss, 4); ss += __shfl_xor(ss, 8);
            const float r = rsqrtf(ss * (1.0f / 128.0f) + NORM_EPS);
            const unsigned wg[4] = {g[gi].x, g[gi].y, g[gi].z, g[gi].w}; unsigned ov[4];
#pragma unroll
            for (int e = 0; e < 4; ++e) ov[e] = cvt_pk_rn(x[2 * e] * r * nw[2 * e] * silu_f(__uint_as_float(wg[e] << 16)), x[2 * e + 1] * r * nw[2 * e + 1] * silu_f(__uint_as_float(wg[e] & 0xffff0000u)));
            *(uint4*)(MIX + (size_t)row * DM + c) = make_uint4(ov[0], ov[1], ov[2], ov[3]); }
    }
}

__device__ __forceinline__ void phase_gemm2(const Params& p, int l, unsigned char* lds, int wv) {
    pg8::Gemm g; g.A = wsb(p, WS_H); g.Bt = wsb(p, WS_WOUTT) + (size_t)l * DM * DM; g.M = M_ALL; g.N = DM; g.K = DM;
    pg8::StaticOrder S; S.init(g.M, g.N, (int)gridDim.x, (int)blockIdx.x);
    pg8::EpiB16 E; E.O = wsb(p, WS_O2); E.ld = DM;
    pg8::gemm_phase<pg8::EpiB16, pg8::StaticOrder>((PG8_LAS unsigned char*)lds, g, S, E, wv);
}

template <bool NEXT>
__device__ __forceinline__ void phase_postnorm(const Params& p, int l, int wv) {
    const int tid = opaque_tid(wv), wid = tid >> 6, lane = tid & 63;
    const float* modl = wsf(p, WS_MOD) + (size_t)l * 9 * MODW; const float* pw = inp(IN_POST_W) + (size_t)l * DM;
    const float* modn = modl + 9 * MODW; const float* pwn = inp(IN_PRE_W) + (size_t)(l + 1) * DM;
    const bf16_t* O2 = wsb(p, WS_O2); bf16_t* H = wsb(p, WS_H);
    for (int row = blockIdx.x * NWAVE + wid; row < M_ALL; row += gridDim.x * NWAVE) {
        const float* x = x_row(p, 0, row); const bf16_t* o2 = O2 + (size_t)row * DM; const int ci = cond_of_row(row);
        float* y = p.out + OUT_Y + (size_t)row * DM; bf16_t* y0 = (bf16_t*)y;
        uint4 v[8]; float4 xa[8], xb[8]; float ss = 0.f;
#pragma unroll
        for (int i = 0; i < 8; ++i) { v[i] = *(const uint4*)(o2 + (i * 64 + lane) * 8);
            if constexpr (NEXT) { xa[i] = *(const float4*)(x + (i * 64 + lane) * 8); xb[i] = *(const float4*)(x + (i * 64 + lane) * 8 + 4); }
            else { const uint4 xv = *(const uint4*)(y0 + (i * 64 + lane) * 8);
                xa[i] = make_float4(__uint_as_float(xv.x << 16), __uint_as_float(xv.x & 0xffff0000u), __uint_as_float(xv.y << 16), __uint_as_float(xv.y & 0xffff0000u));
                xb[i] = make_float4(__uint_as_float(xv.z << 16), __uint_as_float(xv.z & 0xffff0000u), __uint_as_float(xv.w << 16), __uint_as_float(xv.w & 0xffff0000u)); } }
#pragma unroll
        for (int i = 0; i < 8; ++i) {
            const unsigned w4[4] = {v[i].x, v[i].y, v[i].z, v[i].w};
#pragma unroll
            for (int e = 0; e < 4; ++e) { const float a = __uint_as_float(w4[e] << 16), b = __uint_as_float(w4[e] & 0xffff0000u); ss += a * a + b * b; } }
        ss = wave_sum(ss); const float rstd = rsqrtf(ss * (1.0f / DM) + NORM_EPS);
        const float* gt = modl + (size_t)ci * MODW + 2 * DM;
        float yv[8][8]; float ssy = 0.f;
#pragma unroll
        for (int i = 0; i < 8; ++i) { const int col = (i * 64 + lane) * 8;
            const float4 w0 = *(const float4*)(pw + col), w1 = *(const float4*)(pw + col + 4), g0 = *(const float4*)(gt + col), g1 = *(const float4*)(gt + col + 4), x0 = xa[i], x1 = xb[i];
            const unsigned w4[4] = {v[i].x, v[i].y, v[i].z, v[i].w};
            const float ww[8] = {w0.x, w0.y, w0.z, w0.w, w1.x, w1.y, w1.z, w1.w}, gg[8] = {g0.x, g0.y, g0.z, g0.w, g1.x, g1.y, g1.z, g1.w}, xx[8] = {x0.x, x0.y, x0.z, x0.w, x1.x, x1.y, x1.z, x1.w};
#pragma unroll
            for (int e = 0; e < 4; ++e) { const float a = __uint_as_float(w4[e] << 16), b = __uint_as_float(w4[e] & 0xffff0000u);
                yv[i][2 * e] = xx[2 * e] + gg[2 * e] * a * rstd * ww[2 * e]; yv[i][2 * e + 1] = xx[2 * e + 1] + gg[2 * e + 1] * b * rstd * ww[2 * e + 1]; }
            if constexpr (NEXT) *(uint4*)(y0 + col) = make_uint4(cvt_pk_rn(yv[i][0], yv[i][1]), cvt_pk_rn(yv[i][2], yv[i][3]), cvt_pk_rn(yv[i][4], yv[i][5]), cvt_pk_rn(yv[i][6], yv[i][7]));
            else { *(float4*)(y + col) = make_float4(yv[i][0], yv[i][1], yv[i][2], yv[i][3]); *(float4*)(y + col + 4) = make_float4(yv[i][4], yv[i][5], yv[i][6], yv[i][7]); }
            if (NEXT) {
#pragma unroll
                for (int e = 0; e < 8; ++e) ssy += yv[i][e] * yv[i][e]; } }
        if (NEXT) {
            ssy = wave_sum(ssy); const float rsy = rsqrtf(ssy * (1.0f / DM) + NORM_EPS);
            const float* sh = modn + (size_t)ci * MODW; const float* sc = sh + DM;
#pragma unroll
            for (int i = 0; i < 8; ++i) { const int col = (i * 64 + lane) * 8;
                const float4 w0 = *(const float4*)(pwn + col), w1 = *(const float4*)(pwn + col + 4), a0 = *(const float4*)(sc + col), a1 = *(const float4*)(sc + col + 4), b0 = *(const float4*)(sh + col), b1 = *(const float4*)(sh + col + 4);
                const float ww[8] = {w0.x, w0.y, w0.z, w0.w, w1.x, w1.y, w1.z, w1.w}, aa[8] = {a0.x, a0.y, a0.z, a0.w, a1.x, a1.y, a1.z, a1.w}, bb[8] = {b0.x, b0.y, b0.z, b0.w, b1.x, b1.y, b1.z, b1.w};
                unsigned ov[4];
#pragma unroll
                for (int e = 0; e < 4; ++e) ov[e] = cvt_pk_rn(yv[i][2 * e] * rsy * ww[2 * e] * (1.f + aa[2 * e]) + bb[2 * e], yv[i][2 * e + 1] * rsy * ww[2 * e + 1] * (1.f + aa[2 * e + 1]) + bb[2 * e + 1]);
                *(uint4*)(H + (size_t)row * DM + col) = make_uint4(ov[0], ov[1], ov[2], ov[3]); }
        }
    }
}

namespace dn {
using bf16x8 = __attribute__((ext_vector_type(8))) short;
using s16x4 = __attribute__((ext_vector_type(4))) short;
using f32x4 = __attribute__((ext_vector_type(4))) float;
using u32x4 = __attribute__((ext_vector_type(4))) unsigned;
#define DN_LFENCE() asm volatile("s_waitcnt lgkmcnt(0)" ::: "memory")
__device__ __forceinline__ unsigned cvtpk(float lo, float hi) { return cvt_pk_rn(lo, hi); }
__device__ __forceinline__ bf16x8 mk8(uint2 a, uint2 b) { u32x4 w = {a.x, a.y, b.x, b.y}; return *reinterpret_cast<bf16x8*>(&w); }
__device__ __forceinline__ bf16x8 pack8(f32x4 a, f32x4 b) { u32x4 w = {cvtpk(a[0], a[1]), cvtpk(a[2], a[3]), cvtpk(b[0], b[1]), cvtpk(b[2], b[3])}; return *reinterpret_cast<bf16x8*>(&w); }
__device__ __forceinline__ bf16x8 tr_read2(unsigned a0, unsigned a1) {
    s16x4 lo, hi;
    asm volatile("ds_read_b64_tr_b16 %0, %2\n\tds_read_b64_tr_b16 %1, %3\n\ts_waitcnt lgkmcnt(0)" : "=&v"(lo), "=&v"(hi) : "v"(a0), "v"(a1) : "memory");
    return (bf16x8){lo[0], lo[1], lo[2], lo[3], hi[0], hi[1], hi[2], hi[3]};
}
}

__device__ __forceinline__ void phase_dnpre(const Params& p, int l, int wv) {
    const int tid = opaque_tid(wv), wid = tid >> 6, lane = tid & 63, g = lane >> 4, cg = (lane & 15) * 8;
    const bf16_t* ZA = wsb(p, WS_ZA); bf16_t* QKV = wsb(p, WS_QKVR);
    const float* cw = inp(IN_CONV_W) + (size_t)l * 3 * 3072;
    const int ntask = (M_ALL / 4) * 6;
    for (int t = blockIdx.x * NWAVE + wid; t < ntask; t += gridDim.x * NWAVE) {
        const int r4 = t / 6, hg = t % 6, row = r4 * 4 + g;
        int pos, T; if (row < M_CTX) { pos = row & 255; T = 256; } else { pos = (row - M_CTX) & 4095; T = 4096; }
        const bool vm = pos > 0, vp = pos < T - 1;
        uint4 xin[4][3];
#pragma unroll
        for (int hh = 0; hh < 4; ++hh) { const int cbase = (hg * 4 + hh) * 128 + cg; const bf16_t* xr = ZA + (size_t)row * ZA_W + cbase;
            xin[hh][0] = vm ? *(const uint4*)(xr - ZA_W) : make_uint4(0u, 0u, 0u, 0u); xin[hh][1] = *(const uint4*)xr; xin[hh][2] = vp ? *(const uint4*)(xr + ZA_W) : make_uint4(0u, 0u, 0u, 0u); }
#pragma unroll
        for (int hh = 0; hh < 4; ++hh) { const int cbase = (hg * 4 + hh) * 128 + cg;
            float y[8];
#pragma unroll
            for (int e = 0; e < 8; ++e) y[e] = 0.f;
#pragma unroll
            for (int tap = 0; tap < 3; ++tap) { const uint4 a = xin[hh][tap];
                const float4 w0 = *(const float4*)(cw + (size_t)tap * 3072 + cbase), w1 = *(const float4*)(cw + (size_t)tap * 3072 + cbase + 4);
                y[0] += __uint_as_float(a.x << 16) * w0.x; y[1] += __uint_as_float(a.x & 0xffff0000u) * w0.y; y[2] += __uint_as_float(a.y << 16) * w0.z; y[3] += __uint_as_float(a.y & 0xffff0000u) * w0.w;
                y[4] += __uint_as_float(a.z << 16) * w1.x; y[5] += __uint_as_float(a.z & 0xffff0000u) * w1.y; y[6] += __uint_as_float(a.w << 16) * w1.z; y[7] += __uint_as_float(a.w & 0xffff0000u) * w1.w; }
            float ss = 0.f;
#pragma unroll
            for (int e = 0; e < 8; ++e) { y[e] = silu_f(y[e]); ss += y[e] * y[e]; }
            float sc = 1.f;
            if (hg < 4) { ss += __shfl_xor(ss, 1); ss += __shfl_xor(ss, 2); ss += __shfl_xor(ss, 4); ss += __shfl_xor(ss, 8); sc = rsqrtf(ss + NORM_EPS); }
            uint4 o; o.x = dn::cvtpk(y[0] * sc, y[1] * sc); o.y = dn::cvtpk(y[2] * sc, y[3] * sc); o.z = dn::cvtpk(y[4] * sc, y[5] * sc); o.w = dn::cvtpk(y[6] * sc, y[7] * sc);
            *(uint4*)(QKV + (size_t)row * 3072 + cbase) = o; }
    }
}

constexpr int DNB_REGION = 17920;
__device__ __forceinline__ void phase_dnb(const Params& p, int l, unsigned char* lds, int wv) {
    using namespace dn;
    const int tid = opaque_tid(wv), wid = __builtin_amdgcn_readfirstlane(tid >> 6), lane0 = tid & 63;
#define DNB_RELANE() int lane = lane0; asm volatile("" : "+v"(lane)); const int fr = lane & 15, fq = lane >> 4; (void)fr; (void)fq
    unsigned char* R = lds + wid * DNB_REGION;
    float* Rf = (float*)R;
    float* gcs = (float*)(R + 17408); float* bts = gcs + 64;
    const unsigned rb = (unsigned)(uintptr_t)R;
    const bf16_t* QKV = wsb(p, WS_QKVR); const float* AB = wsf(p, WS_AB);
    unsigned char* DNP = p.ws + WS_DNP;
    const float* alog = inp(IN_A_LOG); const float* dtbp = inp(IN_DT_BIAS);
    for (int u = blockIdx.x * NWAVE + wid; u < 9216; u += gridDim.x * NWAVE) {
        const int dir = u & 1, h = (u >> 1) & 7, row0 = (u >> 4) * 64;
        unsigned char* U = DNP + (size_t)u * DN_UNIT;
        const int hq = h * 128, hk = 1024 + h * 128, hv = 2048 + h * 128;
        bf16x8 Kf[4][4];
        { DNB_RELANE();
#pragma unroll
        for (int mt = 0; mt < 4; ++mt) { const int i = 16 * mt + fr; const bf16_t* kr = QKV + (size_t)(row0 + (dir ? 63 - i : i)) * 3072 + hk + 4 * fq;
#pragma unroll
            for (int kk = 0; kk < 4; ++kk) Kf[mt][kk] = mk8(*(const uint2*)(kr + 32 * kk), *(const uint2*)(kr + 32 * kk + 16)); } }
        { DNB_RELANE();
            const float aneg = -__expf(alog[(l * 2 + dir) * 8 + h]), dtb = dtbp[(l * 2 + dir) * 8 + h];
            const float* ab = AB + (size_t)(row0 + (dir ? 63 - lane : lane)) * 32;
            const float al = ab[dir * 8 + h] + dtb; const float ee = __expf(-fabsf(al)); const float sp = fmaxf(al, 0.f) + (ee < 1e-3f ? ee * (1.0f - ee * (0.5f - ee * 0.33333334f)) : __logf(1.0f + ee));
            float g = aneg * sp; const float beta = 1.0f / (1.0f + __expf(-ab[16 + dir * 8 + h]));
#pragma unroll
            for (int o = 1; o < 64; o <<= 1) { const float v = __shfl_up(g, o); if (lane >= o) g += v; }
            gcs[lane] = g; bts[lane] = beta; ((float*)(U + DNU_GC))[lane] = g;
        }
        DN_LFENCE();
        { DNB_RELANE();
#pragma unroll
        for (int mt = 0; mt < 4; ++mt) { const float4 gi = *(const float4*)(gcs + 16 * mt + 4 * fq), bi = *(const float4*)(bts + 16 * mt + 4 * fq);
#pragma unroll
            for (int nt = 0; nt < 4; ++nt) { float o4[4] = {0.f, 0.f, 0.f, 0.f};
                if (nt <= mt) { f32x4 acc = {0.f, 0.f, 0.f, 0.f};
#pragma unroll
                    for (int kk = 0; kk < 4; ++kk) acc = __builtin_amdgcn_mfma_f32_16x16x32_bf16(Kf[mt][kk], Kf[nt][kk], acc, 0, 0, 0);
                    const int j = 16 * nt + fr; const float gj = gcs[j]; const float giv[4] = {gi.x, gi.y, gi.z, gi.w}, biv[4] = {bi.x, bi.y, bi.z, bi.w};
#pragma unroll
                    for (int r = 0; r < 4; ++r) { const int i = 16 * mt + 4 * fq + r; const float e = __expf(fminf(giv[r] - gj, 0.f)); o4[r] = (i > j) ? biv[r] * acc[r] * e : 0.f; } }
#pragma unroll
                for (int r = 0; r < 4; ++r) Rf[(16 * mt + 4 * fq + r) * 68 + 16 * nt + fr] = o4[r]; } } }
        { DNB_RELANE();
#pragma unroll
        for (int mt = 0; mt < 4; ++mt) { const int i = 16 * mt + fr; const bf16_t* qr = QKV + (size_t)(row0 + (dir ? 63 - i : i)) * 3072 + hq + 4 * fq;
            bf16x8 Qf[4];
#pragma unroll
            for (int kk = 0; kk < 4; ++kk) { Qf[kk] = mk8(*(const uint2*)(qr + 32 * kk), *(const uint2*)(qr + 32 * kk + 16)); *(bf16x8*)(U + DNU_Q + ((mt * 4 + kk) * 64 + lane) * 16) = Qf[kk]; }
            const float gi = gcs[i];
#pragma unroll
            for (int k2 = 0; k2 < 2; ++k2) { f32x4 t2[2];
#pragma unroll
                for (int s2 = 0; s2 < 2; ++s2) { const int nt = 2 * k2 + s2; t2[s2] = (f32x4){0.f, 0.f, 0.f, 0.f};
                    if (nt <= mt) { f32x4 acc = {0.f, 0.f, 0.f, 0.f};
#pragma unroll
                        for (int kk = 0; kk < 4; ++kk) acc = __builtin_amdgcn_mfma_f32_16x16x32_bf16(Kf[nt][kk], Qf[kk], acc, 0, 0, 0);
                        const float4 gj = *(const float4*)(gcs + 16 * nt + 4 * fq); const float gjv[4] = {gj.x, gj.y, gj.z, gj.w};
#pragma unroll
                        for (int r = 0; r < 4; ++r) { const int j = 16 * nt + 4 * fq + r; const float e = __expf(fminf(gi - gjv[r], 0.f)); t2[s2][r] = (i >= j) ? ATT_SCALE * acc[r] * e : 0.f; } } }
                *(bf16x8*)(U + DNU_QK + ((mt * 2 + k2) * 64 + lane) * 16) = pack8(t2[0], t2[1]); } } }
        u32x4 tile[16];
        { DNB_RELANE();
#pragma unroll
        for (int it = 0; it < 16; ++it) { const int j = it * 4 + (lane >> 4); tile[it] = *(const u32x4*)(QKV + (size_t)(row0 + (dir ? 63 - j : j)) * 3072 + hk + (lane & 15) * 8); } }
        DN_LFENCE();
        { DNB_RELANE();
        for (int b4 = 0; b4 < 16; ++b4) { const int i0 = 4 * b4;
            float acc[4];
#pragma unroll
            for (int r = 0; r < 4; ++r) acc[r] = -Rf[(i0 + r) * 68 + lane];
#pragma unroll 2
            for (int j = 0; j < i0; j += 4) {
                const float n0 = Rf[(j + 0) * 68 + lane], n1 = Rf[(j + 1) * 68 + lane], n2 = Rf[(j + 2) * 68 + lane], n3 = Rf[(j + 3) * 68 + lane];
#pragma unroll
                for (int r = 0; r < 4; ++r) { const float4 a = *(const float4*)(Rf + (i0 + r) * 68 + j); acc[r] -= (a.x * n0 + a.y * n1) + (a.z * n2 + a.w * n3); } }
            const float4 d1 = *(const float4*)(Rf + (i0 + 1) * 68 + i0), d2 = *(const float4*)(Rf + (i0 + 2) * 68 + i0), d3 = *(const float4*)(Rf + (i0 + 3) * 68 + i0);
            const float x0 = (lane < i0) ? acc[0] : 0.f;
            const float x1 = (lane < i0 + 1) ? acc[1] - d1.x * x0 : 0.f;
            const float x2 = (lane < i0 + 2) ? acc[2] - d2.x * x0 - d2.y * x1 : 0.f;
            const float x3 = (lane < i0 + 3) ? acc[3] - d3.x * x0 - d3.y * x1 - d3.z * x2 : 0.f;
            DN_LFENCE();
            Rf[(i0 + 0) * 68 + lane] = x0; Rf[(i0 + 1) * 68 + lane] = x1; Rf[(i0 + 2) * 68 + lane] = x2; Rf[(i0 + 3) * 68 + lane] = x3;
            DN_LFENCE();
        } }
        bf16x8 T1[4][2], T2[4][2];
        { DNB_RELANE();
#pragma unroll
        for (int mt = 0; mt < 4; ++mt) { const int i = 16 * mt + fr;
#pragma unroll
            for (int k2 = 0; k2 < 2; ++k2) { const int j0 = 32 * k2 + 4 * fq;
                const float4 n0 = *(const float4*)(Rf + i * 68 + j0), n1 = *(const float4*)(Rf + i * 68 + j0 + 16);
                const float4 b0 = *(const float4*)(bts + j0), b1 = *(const float4*)(bts + j0 + 16), g0 = *(const float4*)(gcs + j0), g1 = *(const float4*)(gcs + j0 + 16);
                float tv[8] = {n0.x, n0.y, n0.z, n0.w, n1.x, n1.y, n1.z, n1.w}; const float bv[8] = {b0.x, b0.y, b0.z, b0.w, b1.x, b1.y, b1.z, b1.w}, gv[8] = {g0.x, g0.y, g0.z, g0.w, g1.x, g1.y, g1.z, g1.w};
                float t1[8], t2[8];
#pragma unroll
                for (int e = 0; e < 8; ++e) { const int j = j0 + 16 * (e >> 2) + (e & 3); if (j == i) tv[e] += 1.0f; t1[e] = tv[e] * bv[e]; t2[e] = -t1[e] * __expf(gv[e]); }
                T1[mt][k2] = pack8((f32x4){t1[0], t1[1], t1[2], t1[3]}, (f32x4){t1[4], t1[5], t1[6], t1[7]});
                T2[mt][k2] = pack8((f32x4){t2[0], t2[1], t2[2], t2[3]}, (f32x4){t2[4], t2[5], t2[6], t2[7]});
                __builtin_amdgcn_sched_barrier(0); } } }
        DN_LFENCE();
        { DNB_RELANE();
#pragma unroll
        for (int it = 0; it < 16; ++it) { const int j = it * 4 + (lane >> 4); *(u32x4*)(R + j * 256 + (lane & 15) * 16) = tile[it]; }
#pragma unroll
        for (int it = 0; it < 16; ++it) { const int j = it * 4 + (lane >> 4); tile[it] = *(const u32x4*)(QKV + (size_t)(row0 + (dir ? 63 - j : j)) * 3072 + hv + (lane & 15) * 8); }
        DN_LFENCE();
        const unsigned tra = rb + (4 * fq + ((lane & 15) >> 2)) * 256 + (lane & 3) * 8;
#pragma unroll
        for (int kk = 0; kk < 4; ++kk) { bf16x8 KT[2][2];
#pragma unroll
            for (int s2 = 0; s2 < 2; ++s2)
#pragma unroll
                for (int k2 = 0; k2 < 2; ++k2) { const int m8 = 2 * kk + s2; const unsigned a0 = tra + (32 * k2) * 256 + m8 * 32; KT[s2][k2] = tr_read2(a0, a0 + 16 * 256);
                    *(bf16x8*)(U + DNU_KT + ((m8 * 2 + k2) * 64 + lane) * 16) = KT[s2][k2]; }
#pragma unroll
            for (int mt = 0; mt < 4; ++mt) { f32x4 w0 = {0.f, 0.f, 0.f, 0.f}, w1 = {0.f, 0.f, 0.f, 0.f};
                w0 = __builtin_amdgcn_mfma_f32_16x16x32_bf16(KT[0][0], T2[mt][0], w0, 0, 0, 0); w0 = __builtin_amdgcn_mfma_f32_16x16x32_bf16(KT[0][1], T2[mt][1], w0, 0, 0, 0);
                w1 = __builtin_amdgcn_mfma_f32_16x16x32_bf16(KT[1][0], T2[mt][0], w1, 0, 0, 0); w1 = __builtin_amdgcn_mfma_f32_16x16x32_bf16(KT[1][1], T2[mt][1], w1, 0, 0, 0);
                *(bf16x8*)(U + DNU_W + ((mt * 4 + kk) * 64 + lane) * 16) = pack8(w0, w1); } }
        DN_LFENCE();
#pragma unroll
        for (int it = 0; it < 16; ++it) { const int j = it * 4 + (lane >> 4); *(u32x4*)(R + j * 256 + (lane & 15) * 16) = tile[it]; }
        DN_LFENCE();
#pragma unroll
        for (int n8 = 0; n8 < 8; ++n8) { const unsigned a0 = tra + n8 * 32;
            const bf16x8 V0 = tr_read2(a0, a0 + 16 * 256), V1 = tr_read2(a0 + 32 * 256, a0 + 48 * 256);
#pragma unroll
            for (int mt = 0; mt < 4; ++mt) { f32x4 acc = {0.f, 0.f, 0.f, 0.f};
                acc = __builtin_amdgcn_mfma_f32_16x16x32_bf16(T1[mt][0], V0, acc, 0, 0, 0); acc = __builtin_amdgcn_mfma_f32_16x16x32_bf16(T1[mt][1], V1, acc, 0, 0, 0);
                uint2 w; w.x = cvtpk(acc[0], acc[1]); w.y = cvtpk(acc[2], acc[3]);
                *(uint2*)(U + DNU_U + ((n8 * 4 + mt) * 64 + lane) * 8) = w; } }
        DN_LFENCE(); }
    }
#undef DNB_RELANE
}

constexpr int DNS_BUF = 65792;
__device__ __forceinline__ void phase_dnscan(const Params& p, int l, unsigned char* lds, int wv) {
    using namespace dn;
    const int tid = opaque_tid(wv), wid = __builtin_amdgcn_readfirstlane(tid >> 6), lane0 = tid & 63;
    const unsigned char* DNP = p.ws + WS_DNP; bf16_t* DNO = wsb(p, WS_DNO);
    for (int u = blockIdx.x; u < 768; u += gridDim.x) {
        int b, NC, row0; const bool lat = u < 256;
        const int v = lat ? u : u - 256, cidx = (v & 7) | ((v >> 4) << 3), half = (v >> 3) & 1; b = cidx >> 4; const int h = (cidx >> 1) & 7, dir = cidx & 1;
        if (lat) { NC = 64; row0 = M_CTX + b * 4096; } else { NC = 4; row0 = b * 256; }
        const int gch0 = row0 >> 6;
        const int dv0 = (half * 4 + wid) * 16;
        const int lt0 = tid - 256;
#define DNS_LOAD(S, G, n) do { const int _cn = dir ? NC - 1 - (n) : (n); const unsigned char* _rec = DNP + (size_t)(((gch0 + _cn) * 8 + h) * 2 + dir) * DN_UNIT; \
        _Pragma("unroll") for (int _i = 0; _i < 16; ++_i) { const int _q = lt + 256 * _i; \
            S[_i] = *(const u32x4*)(_rec + (_q < 3584 ? _q * 16 : DNU_U + half * 8192 + (_q - 3584) * 16)); } \
        if (lt < 16) G = *(const u32x4*)(_rec + DNU_GC + lt * 16); } while (0)
#define DNS_STORE(S, G, bufp) do { _Pragma("unroll") for (int _i = 0; _i < 16; ++_i) *(u32x4*)((bufp) + (lt + 256 * _i) * 16) = S[_i]; \
        if (lt < 16) *(u32x4*)((bufp) + 65536 + lt * 16) = G; } while (0)
        if (wid < 4) {
            f32x4 S[8]; bf16x8 SB[4];
            { int lane = lane0; asm volatile("" : "+v"(lane)); const int fr = lane & 15, fq = lane >> 4;
            if (lat) { const float* s0 = inp(IN_STATE_DN) + ((((size_t)b * 2 + l) * 2 + dir) * 8 + h) * 128 * 128;
#pragma unroll
                for (int m8 = 0; m8 < 8; ++m8)
#pragma unroll
                    for (int r = 0; r < 4; ++r) S[m8][r] = s0[(size_t)(16 * m8 + 4 * fq + r) * 128 + dv0 + fr]; }
            else {
#pragma unroll
                for (int m8 = 0; m8 < 8; ++m8) S[m8] = (f32x4){0.f, 0.f, 0.f, 0.f}; }
#pragma unroll
            for (int kk = 0; kk < 4; ++kk) SB[kk] = pack8(S[2 * kk], S[2 * kk + 1]);
        }
            __syncthreads();
            __syncthreads();
            for (int n = 0; n < NC; ++n) {
                unsigned char* buf = lds + (n & 1) * DNS_BUF;
                int lane = lane0; asm volatile("" : "+v"(lane)); const int fr = lane & 15, fq = lane >> 4;
                const int cn = dir ? NC - 1 - n : n; const int t0 = row0 + cn * 64;
                const float gl = *(const float*)(buf + 65536 + 63 * 4);
                f32x4 vn[4];
#pragma unroll
                for (int mt = 0; mt < 4; ++mt) { const uint2 uu = *(const uint2*)(buf + 57344 + ((wid * 4 + mt) * 64 + lane) * 8);
                    vn[mt] = (f32x4){__uint_as_float(uu.x << 16), __uint_as_float(uu.x & 0xffff0000u), __uint_as_float(uu.y << 16), __uint_as_float(uu.y & 0xffff0000u)};
#pragma unroll
                    for (int kk = 0; kk < 4; ++kk) vn[mt] = __builtin_amdgcn_mfma_f32_16x16x32_bf16(*(const bf16x8*)(buf + DNU_W + ((mt * 4 + kk) * 64 + lane) * 16), SB[kk], vn[mt], 0, 0, 0); }
                const bf16x8 VB0 = pack8(vn[0], vn[1]), VB1 = pack8(vn[2], vn[3]);
                f32x4 eh[4];
#pragma unroll
                for (int mt = 0; mt < 4; ++mt) { const float4 gi = *(const float4*)(buf + 65536 + (16 * mt + 4 * fq) * 4);
                    f32x4 oa = {0.f, 0.f, 0.f, 0.f};
#pragma unroll
                    for (int kk = 0; kk < 4; ++kk) oa = __builtin_amdgcn_mfma_f32_16x16x32_bf16(*(const bf16x8*)(buf + DNU_Q + ((mt * 4 + kk) * 64 + lane) * 16), SB[kk], oa, 0, 0, 0);
                    oa[0] *= ATT_SCALE * __expf(gi.x); oa[1] *= ATT_SCALE * __expf(gi.y); oa[2] *= ATT_SCALE * __expf(gi.z); oa[3] *= ATT_SCALE * __expf(gi.w);
                    eh[mt] = (f32x4){__expf(gl - gi.x), __expf(gl - gi.y), __expf(gl - gi.z), __expf(gl - gi.w)};
                    oa = __builtin_amdgcn_mfma_f32_16x16x32_bf16(*(const bf16x8*)(buf + DNU_QK + ((mt * 2 + 0) * 64 + lane) * 16), VB0, oa, 0, 0, 0);
                    oa = __builtin_amdgcn_mfma_f32_16x16x32_bf16(*(const bf16x8*)(buf + DNU_QK + ((mt * 2 + 1) * 64 + lane) * 16), VB1, oa, 0, 0, 0);
#pragma unroll
                    for (int r = 0; r < 4; ++r) { const int i = 16 * mt + 4 * fq + r;
                        DNO[((size_t)dir * M_ALL + t0 + (dir ? 63 - i : i)) * 1024 + h * 128 + dv0 + fr] = f2bf(oa[r]); } }
                const bf16x8 WB0 = pack8(vn[0] * eh[0], vn[1] * eh[1]), WB1 = pack8(vn[2] * eh[2], vn[3] * eh[3]);
                const float eg = __expf(gl);
#pragma unroll
                for (int m8 = 0; m8 < 8; ++m8) { S[m8] = S[m8] * eg;
                    S[m8] = __builtin_amdgcn_mfma_f32_16x16x32_bf16(*(const bf16x8*)(buf + DNU_KT + ((m8 * 2 + 0) * 64 + lane) * 16), WB0, S[m8], 0, 0, 0);
                    S[m8] = __builtin_amdgcn_mfma_f32_16x16x32_bf16(*(const bf16x8*)(buf + DNU_KT + ((m8 * 2 + 1) * 64 + lane) * 16), WB1, S[m8], 0, 0, 0); }
#pragma unroll
                for (int kk = 0; kk < 4; ++kk) SB[kk] = pack8(S[2 * kk], S[2 * kk + 1]);
                __syncthreads();
            }
            if (!lat) { int lane = lane0; asm volatile("" : "+v"(lane)); const int fr = lane & 15, fq = lane >> 4; float* so = p.out + OUT_ST + ((((size_t)b * 2 + l) * 2 + dir) * 8 + h) * 128 * 128;
#pragma unroll
            for (int m8 = 0; m8 < 8; ++m8)
#pragma unroll
                for (int r = 0; r < 4; ++r) so[(size_t)(16 * m8 + 4 * fq + r) * 128 + dv0 + fr] = S[m8][r]; }
        } else {
            u32x4 sa[16], sb[16], ga = {0u, 0u, 0u, 0u}, gb = {0u, 0u, 0u, 0u};
            __syncthreads();
            { int lt = lt0; asm volatile("" : "+v"(lt)); DNS_LOAD(sa, ga, 0); if (NC > 1) DNS_LOAD(sb, gb, 1); DNS_STORE(sa, ga, lds); }
            __syncthreads();
            for (int n = 0; n < NC; ++n) { unsigned char* nbuf = lds + ((n + 1) & 1) * DNS_BUF;
                int lt = lt0; asm volatile("" : "+v"(lt));
                if (n & 1) { if (n + 2 < NC) DNS_LOAD(sb, gb, n + 2); if (n + 1 < NC) DNS_STORE(sa, ga, nbuf); }
                else { if (n + 2 < NC) DNS_LOAD(sa, ga, n + 2); if (n + 1 < NC) DNS_STORE(sb, gb, nbuf); }
                __syncthreads();
            }
        }
#undef DNS_LOAD
#undef DNS_STORE
    }
}

enum { PH_MOD = 0, PH_CVT, PH_PRENORM, PH_GEMM1, PH_ATTNPREP, PH_DNPRE, PH_ATTN, PH_DNB, PH_DNSCAN, PH_DNCOMB, PH_GEMM2, PH_POSTNORM };

__global__ void __launch_bounds__(NTHR, 2) mega(Params p) {
    extern __shared__ __attribute__((aligned(16))) unsigned char lds[];
    const bool all = p.phase < 0;
    const int wv = __builtin_amdgcn_readfirstlane((int)(threadIdx.x >> 6));
    XcdBarrier bar;
    if (threadIdx.x == 0) {
        *(uint4*)(lds + LDS_CTL_OFF) = make_uint4(0u, 0u, 0u, 0u);
#pragma unroll
        for (int i = 0; i < IN_COUNT; ++i) *(unsigned long long*)(lds + LDS_TAB_OFF + i * 8) = (unsigned long long)p.in[i];
    }
    __syncthreads();
    if (all) {
        bar = xcd_barrier_post((unsigned*)(p.ws + WS_CTL), (volatile LAS unsigned*)(lds + LDS_CTL_OFF));
    }
#define SEAM() do { if (all) xcd_barrier(bar); } while (0)
#ifdef TEST_ONLY
#define RUN(id) ((id) == TEST_ONLY && (all || p.phase == (id)))
#else
#define RUN(id) (all || p.phase == (id))
#endif
    if (RUN(PH_MOD)) phase_mod(p, lds, wv);
    if (RUN(PH_CVT)) phase_cvt(p, lds, wv);
    SEAM();
    const int l0 = all ? 0 : p.layer, l1 = all ? 2 : p.layer + 1;
    for (int l = l0; l < l1; ++l) {
        if (l == 0) { if (RUN(PH_PRENORM)) phase_prenorm(p, l, wv); SEAM(); }
        if (RUN(PH_GEMM1)) phase_gemm1(p, l, lds, wv);
        SEAM();
        if (RUN(PH_ATTNPREP)) phase_attnprep(p, l, lds, wv);
        if (RUN(PH_DNPRE)) phase_dnpre(p, l, wv);
        SEAM();
        if (RUN(PH_ATTN)) phase_attn(p, l, lds, wv);
        SEAM();
        if (RUN(PH_DNB)) phase_dnb(p, l, lds, wv);
        SEAM();
        if (RUN(PH_DNSCAN)) phase_dnscan(p, l, lds, wv);
        SEAM();
        if (RUN(PH_DNCOMB)) phase_dncomb(p, l, wv);
        SEAM();
        if (RUN(PH_GEMM2)) phase_gemm2(p, l, lds, wv);
        SEAM();
        if (RUN(PH_POSTNORM)) { if (l == 0) phase_postnorm<true>(p, l, wv); else phase_postnorm<false>(p, l, wv); }
        SEAM();
    }
#undef SEAM
#undef RUN
}

#ifndef MK_FUSED
#define MK_FUSED 1
#endif

extern "C" void kernel_launch(void* const* d_in, const int* in_sizes, int n_in, void* d_out, int out_size, void* d_ws, size_t ws_size, hipStream_t stream) {
    static int grid = 0;
    if (grid == 0) {
        if (n_in != 23 || ws_size < WS_END) { fprintf(stderr, "kernel_launch: unexpected n_in %d / ws_size %zu (need %zu)\n", n_in, ws_size, WS_END); return; }
        int dev = 0, cus = 0, per_cu = 0;
        if (hipGetDevice(&dev) != hipSuccess || hipDeviceGetAttribute(&cus, hipDeviceAttributeMultiprocessorCount, dev) != hipSuccess) { fprintf(stderr, "kernel_launch: device query failed\n"); return; }
        if (hipFuncSetAttribute((const void*)mega, hipFuncAttributeMaxDynamicSharedMemorySize, LDS_BYTES) != hipSuccess) { fprintf(stderr, "kernel_launch: hipFuncSetAttribute failed\n"); return; }
        if (hipOccupancyMaxActiveBlocksPerMultiprocessor(&per_cu, (const void*)mega, NTHR, LDS_BYTES) != hipSuccess || per_cu < 1) { fprintf(stderr, "kernel_launch: occupancy query says %d\n", per_cu); return; }
        grid = cus;
    }
    Params p; memset(&p, 0, sizeof(p));
    for (int i = 0; i < IN_COUNT; ++i) p.in[i] = (const float*)d_in[i];
    p.out = (float*)d_out; p.ws = (unsigned char*)d_ws;
#if MK_FUSED
    hipMemsetAsync((char*)d_ws + WS_CTL, 0, CTL_BYTES, stream);
    p.phase = -1; p.layer = 0;
    hipLaunchKernelGGL(mega, dim3(grid), dim3(NTHR), LDS_BYTES, stream, p);
#else
    p.phase = PH_MOD; p.layer = 0; hipLaunchKernelGGL(mega, dim3(grid), dim3(NTHR), LDS_BYTES, stream, p);
    p.phase = PH_CVT; hipLaunchKernelGGL(mega, dim3(grid), dim3(NTHR), LDS_BYTES, stream, p);
    for (int l = 0; l < 2; ++l)
        for (int ph = PH_PRENORM; ph <= PH_POSTNORM; ++ph) { if ((l == 1 && ph == PH_PRENORM)) continue; p.phase = ph; p.layer = l; hipLaunchKernelGGL(mega, dim3(grid), dim3(NTHR), LDS_BYTES, stream, p); }
#endif
    const hipError_t le = hipPeekAtLastError();
    if (le != hipSuccess) fprintf(stderr, "kernel_launch: launch failed: %s\n", hipGetErrorName(le));
}
```

```cpp
#include <hip/hip_runtime.h>
#include <cstdio>
#include <cstdint>
#include <cstring>

typedef unsigned short bf16_t;
#define LAS __attribute__((address_space(3)))

constexpr int DM = 4096;
constexpr int M_CTX = 16 * 256;
constexpr int M_LAT = 8 * 4096;
constexpr int M_ALL = M_CTX + M_LAT;
constexpr int IN_COLS = 13344;
constexpr int NPAD = 13568;
constexpr int ZA_W = 4096, ZB_W = 5120, ZC_W = 4096;
constexpr int MODW = 3 * DM;
constexpr float NORM_EPS = 1e-6f;
constexpr float ATT_SCALE = 0.088388347648318440f;

constexpr size_t MiB = (size_t)1 << 20;
constexpr size_t WS_CTL = 0;
constexpr size_t CTL_BYTES = 64 * 1024;
constexpr size_t WS_MOD = 1 * MiB;
constexpr size_t WS_ROPE = 2 * MiB;
constexpr size_t WS_CKM = WS_ROPE + 32768;
constexpr size_t WS_KP = WS_ROPE + 65536;
constexpr int KP_STRIDE = 288;
constexpr size_t WS_WINT = 3 * MiB;
constexpr size_t WS_WOUTT = WS_WINT + (size_t)2 * NPAD * DM * 2;
constexpr size_t WS_H = WS_WOUTT + (size_t)2 * DM * DM * 2;
constexpr size_t WS_ZA = WS_H + (size_t)M_ALL * DM * 2;
constexpr size_t WS_ZB = WS_ZA + (size_t)M_ALL * ZA_W * 2;
constexpr size_t WS_ZC = WS_ZB + (size_t)M_ALL * ZB_W * 2;
constexpr size_t WS_DTMP = WS_ZC + (size_t)M_ALL * ZC_W * 2;
constexpr size_t WS_AB = WS_DTMP + (size_t)2 * M_ALL * 1024 * 2;
constexpr size_t WS_CKG = WS_AB + (size_t)M_ALL * 32 * 4;
constexpr size_t WS_CVG = WS_CKG + (size_t)8 * 2 * 256 * 512 * 2;
constexpr size_t WS_CKD = WS_CVG + (size_t)8 * 2 * 256 * 512 * 2;
constexpr size_t WS_CVD = WS_CKD + (size_t)8 * 2 * 256 * 1024 * 2;
constexpr size_t WS_DNO = WS_CVD + (size_t)8 * 2 * 256 * 1024 * 2;
constexpr size_t WS_END = WS_DNO + (size_t)2 * M_ALL * 1024 * 4;
constexpr size_t WS_QKVR = WS_DNO;
constexpr int DN_UNIT = 73984, DNU_W = 0, DNU_Q = 16384, DNU_KT = 32768, DNU_QK = 49152, DNU_U = 57344, DNU_GC = 73728;
constexpr size_t WS_DNP = WS_ZB;
static_assert((size_t)9216 * DN_UNIT <= WS_AB - WS_ZB, "DNP overlay");
static_assert((size_t)M_ALL * 3072 * 2 <= (size_t)2 * M_ALL * 1024 * 4, "QKVR overlay");
constexpr size_t WS_O2 = WS_ZA;
static_assert(WS_END <= (size_t)2048 * MiB, "workspace");

constexpr size_t OUT_Y = 0;
constexpr size_t OUT_GK = (size_t)M_ALL * DM;
constexpr size_t OUT_GV = OUT_GK + (size_t)16 * 2 * 256 * 512;
constexpr size_t OUT_DK = OUT_GV + (size_t)16 * 2 * 256 * 512;
constexpr size_t OUT_DV = OUT_DK + (size_t)16 * 2 * 256 * 1024;
constexpr size_t OUT_ST = OUT_DV + (size_t)16 * 2 * 256 * 1024;

enum { IN_X_PROMPT, IN_X_SAMPLE, IN_CACHE_GQA_K, IN_CACHE_GQA_V, IN_CACHE_DIFF_K, IN_CACHE_DIFF_V, IN_STATE_DN, IN_C, IN_C_CTX, IN_W_MOD, IN_B_MOD, IN_PRE_W, IN_POST_W, IN_W_IN, IN_W_OUT, IN_CONV_W, IN_A_LOG, IN_DT_BIAS, IN_DN_NORM_W, IN_Q_NORM_W, IN_K_NORM_W, IN_DIFF_LAMBDA, IN_DIFF_NORM_W, IN_COUNT };
struct Params {
    const float* in[IN_COUNT];
    float* out;
    unsigned char* ws;
    int phase, layer;
};
constexpr int LDS_CTL_OFF = 146432;
constexpr int LDS_TAB_OFF = LDS_CTL_OFF + 64;
constexpr int LDS_BYTES = LDS_CTL_OFF + 1024;
__device__ __forceinline__ const float* inp(int idx) {
    extern __shared__ __attribute__((aligned(16))) unsigned char dyn_lds_[];
    const uint2 v = *(const uint2*)(dyn_lds_ + LDS_TAB_OFF + idx * 8);
    const unsigned lo = __builtin_amdgcn_readfirstlane(v.x), hi = __builtin_amdgcn_readfirstlane(v.y);
    return (const float*)(((unsigned long long)hi << 32) | (unsigned long long)lo);
}

__device__ __forceinline__ float bf2f(bf16_t b) { return __uint_as_float(((unsigned)b) << 16); }
__device__ __forceinline__ bf16_t f2bf(float f) { unsigned u = __float_as_uint(f); u += 0x7FFFu + ((u >> 16) & 1u); return (bf16_t)(u >> 16); }
__device__ __forceinline__ unsigned pk2bf(float lo, float hi) { return (unsigned)f2bf(lo) | ((unsigned)f2bf(hi) << 16); }
typedef float f32x2_t __attribute__((ext_vector_type(2)));
typedef __bf16 bf16x2_t __attribute__((ext_vector_type(2)));
__device__ __forceinline__ unsigned cvt_pk_rn(float lo, float hi) { const f32x2_t v = {lo, hi}; const bf16x2_t r = __builtin_convertvector(v, bf16x2_t); return __builtin_bit_cast(unsigned, r); }
__device__ __forceinline__ float shfl_xor_at(float v, int mask, int lane_l) { return __int_as_float(__builtin_amdgcn_ds_bpermute((lane_l ^ mask) << 2, __float_as_int(v))); }
__device__ __forceinline__ float shfl_up_at(float v, int d, int lane_l) { return __int_as_float(__builtin_amdgcn_ds_bpermute((lane_l - d) << 2, __float_as_int(v))); }
__device__ __forceinline__ float wave_sum_at(float v, int lane_l) {
#pragma unroll
    for (int o = 32; o >= 1; o >>= 1) v += shfl_xor_at(v, o, lane_l);
    return v;
}
#define wave_sum(v) wave_sum_at((v), lane)
#define __shfl_xor(v, m) shfl_xor_at((v), (m), lane)
#define __shfl_up(v, d) shfl_up_at((v), (d), lane)
__device__ __forceinline__ float silu_f(float x) { return x * __builtin_amdgcn_rcpf(1.0f + __expf(-x)); }
__device__ __forceinline__ int cond_of_row(int row) { return row < M_CTX ? 0 : 1 + ((row - M_CTX) >> 12); }

__device__ __forceinline__ int opaque_tid(int wv) { int l; asm volatile("v_mbcnt_lo_u32_b32 %0, -1, 0\n\tv_mbcnt_hi_u32_b32 %0, -1, %0" : "=v"(l)); return wv * 64 + l; }

#define XB_TMO      128
#define XB_XCNT(j)  (256  + 64 * (j))
#define XB_XSUB(j)  (1280 + 64 * (j))
#define XB_XGEN(j)  (2304 + 64 * (j))
#define XB_TOP      3328
#define XB_TOPGEN   3392
#define XCD_BAR_WORDS 3456
#define XB_SPIN_CAP (1u << 22)

__device__ __forceinline__ unsigned xb_ld(unsigned* p)              { return __hip_atomic_load(p, __ATOMIC_RELAXED, __HIP_MEMORY_SCOPE_AGENT); }
__device__ __forceinline__ unsigned xb_add(unsigned* p, unsigned v) { return __hip_atomic_fetch_add(p, v, __ATOMIC_RELAXED, __HIP_MEMORY_SCOPE_AGENT); }
__device__ __forceinline__ unsigned xb_xcc_id() { return (unsigned)__builtin_amdgcn_s_getreg((3 << 11) | 20) & 0xFu; }
#define XB_SPIN(cond, bar) do { unsigned _sp = 0; while (cond) { __builtin_amdgcn_s_sleep(1); \
    if ((++_sp & 255u) == 0u) { if (xb_ld(&(bar)[XB_TMO])) break; if (_sp > XB_SPIN_CAP) { atomicAdd(&(bar)[XB_TMO], 1u); break; } } } } while (0)

struct XcdBarrier {
    unsigned* bar; unsigned x;
    volatile LAS unsigned* st;
};

__device__ __forceinline__ XcdBarrier xcd_barrier_post(unsigned* bar, volatile LAS unsigned* st) {
    XcdBarrier b; b.bar = bar; b.x = xb_xcc_id(); b.st = st;
    if (threadIdx.x == 0) (void)xb_add(&bar[XB_XCNT(b.x)], 1u);
    return b;
}
__device__ __forceinline__ void xcd_barrier_complete(unsigned* bar, unsigned x, unsigned& nloc, unsigned& nx) {
    const unsigned G = gridDim.x * gridDim.y * gridDim.z;
    unsigned sum, cnt, mine, sp = 0u;
    for (;;) {
        sum = 0u; cnt = 0u; mine = 0u;
#pragma unroll
        for (unsigned j = 0; j < 16; ++j) { const unsigned c = xb_ld(&bar[XB_XCNT(j)]); sum += c; cnt += (c > 0u) ? 1u : 0u; mine = (j == x) ? c : mine; }
        if (sum == G) break;
        __builtin_amdgcn_s_sleep(1);
        if ((++sp & 255u) == 0u) { if (xb_ld(&bar[XB_TMO])) break; if (sp > XB_SPIN_CAP) { atomicAdd(&bar[XB_TMO], 1u); break; } }
    }
    nloc = mine > 0u ? mine : 1u; nx = cnt > 0u ? cnt : 1u;
}

__device__ __forceinline__ void xcd_barrier(const XcdBarrier& b) {
    asm volatile("s_waitcnt vmcnt(0)" ::: "memory");
    __syncthreads();
    if (threadIdx.x == 0) {
        unsigned blo = __builtin_amdgcn_readfirstlane((unsigned)(unsigned long long)b.bar), bhi = __builtin_amdgcn_readfirstlane((unsigned)((unsigned long long)b.bar >> 32)), bx = __builtin_amdgcn_readfirstlane(b.x);
        asm volatile("" : "+s"(blo), "+s"(bhi), "+s"(bx));
        unsigned* bar = (unsigned*)(((unsigned long long)bhi << 32) | (unsigned long long)blo);
        __builtin_amdgcn_s_waitcnt(0);
        unsigned nloc = b.st[0], nx = b.st[1];
        if (nloc == 0u) { xcd_barrier_complete(bar, bx, nloc, nx); b.st[0] = nloc; b.st[1] = nx; }
        const unsigned old = xb_add(&bar[XB_XSUB(bx)], 1u);
        const unsigned gen = old / nloc;
        if (old + 1u == (gen + 1u) * nloc) {
            __builtin_amdgcn_fence(__ATOMIC_RELEASE, "agent");
            asm volatile("s_waitcnt vmcnt(0)" ::: "memory");
            const unsigned og = xb_add(&bar[XB_TOP], 1u);
            const unsigned tg = og / nx;
            if (og + 1u == (tg + 1u) * nx) xb_add(&bar[XB_TOPGEN], 1u);
            else XB_SPIN(xb_ld(&bar[XB_TOPGEN]) == tg, bar);
            __builtin_amdgcn_fence(__ATOMIC_ACQUIRE, "agent");
            xb_add(&bar[XB_XGEN(bx)], 1u);
            asm volatile("s_waitcnt vmcnt(0)" ::: "memory");
        } else {
            XB_SPIN(xb_ld(&bar[XB_XGEN(bx)]) == gen, bar);
            __builtin_amdgcn_fence(__ATOMIC_ACQUIRE, "agent");
            asm volatile("s_waitcnt vmcnt(0)" ::: "memory");
        }
    }
    __syncthreads();
}
namespace pg8 {
#define PG8_LAS __attribute__((address_space(3)))
typedef unsigned short bf16_t;
typedef short bf16x8 __attribute__((ext_vector_type(8)));
typedef float f32x4 __attribute__((ext_vector_type(4)));
typedef unsigned u32x4 __attribute__((ext_vector_type(4)));
constexpr int BM = 256, BK = 64, HALF = 128, HTB = HALF * BK * 2  , STAGE_BYTES = 8 * HTB, NXCD = 8, WGM = 4;

__host__ __device__ __forceinline__ int lds_byte(int r, int c) { const int st = (r >> 4) * 2 + (c >> 5), rr = r & 15, cc = c & 31, ob = rr * 64 + cc * 2; return st * 1024 + (ob ^ (((ob >> 9) & 1) << 5)); }
__host__ __device__ __forceinline__ void stage_rc(int b, int& R, int& C) { const int st = b / 1024, sb = b % 1024, swz = sb ^ (((sb >> 9) & 1) << 5); R = (st >> 1) * 16 + swz / 64; C = (st & 1) * 32 + (swz % 64) / 2; }
__host__ __device__ __forceinline__ int perm32(int rho) { const int n = rho >> 4, i = rho & 15; return 8 * (i >> 2) + 4 * n + (i & 3); }

struct Unit { int pm, pn; };
struct Gemm { const bf16_t* A; const bf16_t* Bt; int M, N, K; };

struct StaticOrder {
    int nM, nN, nwg, G, c, nch;
    __host__ __device__ void init(int M, int N, int G_, int c_, int nch_ = 1) { nM = M / BM; nN = N / BM; nwg = nM * nN; G = G_; c = c_; nch = nch_; }
    __host__ __device__ bool next(int i, Unit& u) const {
        long L = (long)i * G + c; if (L >= nwg) return false;
        const int base = nN / nch, extra = nN % nch; int off = 0, wN = base + (extra > 0 ? 1 : 0);
        for (int ch = 0; ch < nch; ++ch) { wN = base + (ch < extra ? 1 : 0); const long cnt = (long)nM * wN; if (L < cnt) break; L -= cnt; off += wN; }
        const int nwc = nM * wN;
        int wgid = (int)L; { const int q = nwc / NXCD, r = nwc % NXCD, xcd = wgid % NXCD, o2 = wgid / NXCD; wgid = (xcd < r ? xcd * (q + 1) : r * (q + 1) + (xcd - r) * q) + o2; }
        const int nig = WGM * wN, gid = wgid / nig, fm = gid * WGM, gsz = (nM - fm) < WGM ? (nM - fm) : WGM;
        u.pm = fm + ((wgid % nig) % gsz); u.pn = off + (wgid % nig) / gsz; return true;
    }
    __device__ __forceinline__ void a_ready(const Unit&) const {}
    __device__ __forceinline__ void done(const Unit&) const {}
};

__device__ __forceinline__ unsigned cvt_pk_bf16(float lo, float hi) { return cvt_pk_rn(lo, hi); }

struct EpiF32 {
    static constexpr bool PERM = false, AFTER_DRAIN = false;
    float* C; int ldc;
    __device__ __forceinline__ void operator()(const f32x4 (&acc)[2][2][4][2], const Unit& u, int wr, int wc, int fr, int fq) const {
        const int row0 = u.pm * BM + wr * 64 + fr, col0 = u.pn * BM + wc * 32 + 4 * fq;
#pragma unroll
        for (int ai = 0; ai < 2; ++ai)
#pragma unroll
            for (int m = 0; m < 4; ++m) { float* rowp = C + (size_t)(row0 + ai * HALF + m * 16) * ldc + col0;
#pragma unroll
                for (int bj = 0; bj < 2; ++bj)
#pragma unroll
                    for (int n = 0; n < 2; ++n) *(f32x4*)(rowp + bj * HALF + n * 16) = acc[ai][bj][m][n]; }
    }
};
struct EpiB16 {
    static constexpr bool PERM = true, AFTER_DRAIN = false;
    bf16_t* O; int ld;
    __device__ __forceinline__ void operator()(const f32x4 (&acc)[2][2][4][2], const Unit& u, int wr, int wc, int fr, int fq) const {
        const int row0 = u.pm * BM + wr * 64 + fr, col0 = u.pn * BM + wc * 32 + 8 * fq;
#pragma unroll
        for (int ai = 0; ai < 2; ++ai)
#pragma unroll
            for (int m = 0; m < 4; ++m) { bf16_t* rowp = O + (size_t)(row0 + ai * HALF + m * 16) * ld + col0;
#pragma unroll
                for (int bj = 0; bj < 2; ++bj) { const f32x4 v0 = acc[ai][bj][m][0], v1 = acc[ai][bj][m][1];
                    u32x4 w; w.x = cvt_pk_bf16(v0[0], v0[1]); w.y = cvt_pk_bf16(v0[2], v0[3]); w.z = cvt_pk_bf16(v1[0], v1[1]); w.w = cvt_pk_bf16(v1[2], v1[3]);
                    *(u32x4*)(rowp + bj * HALF) = w; } }
    }
};
struct EpiZ {
    static constexpr bool PERM = true, AFTER_DRAIN = false;
    bf16_t *ZA, *ZB, *ZC; float* AB;
    __device__ __forceinline__ void operator()(const f32x4 (&acc)[2][2][4][2], const Unit& u, int wr, int wc, int fr, int fq) const {
        const int row0 = u.pm * BM + wr * 64 + fr;
        if (u.pn < 52) {
            bf16_t* base; int ld, colt;
            if (u.pn < 16) { base = ZA; ld = 4096; colt = u.pn * BM; }
            else if (u.pn < 36) { base = ZB; ld = 5120; colt = (u.pn - 16) * BM; }
            else { base = ZC; ld = 4096; colt = (u.pn - 36) * BM; }
            const int col0 = colt + wc * 32 + 8 * fq;
#pragma unroll
            for (int ai = 0; ai < 2; ++ai)
#pragma unroll
                for (int m = 0; m < 4; ++m) { bf16_t* rowp = base + (size_t)(row0 + ai * HALF + m * 16) * ld + col0;
#pragma unroll
                    for (int bj = 0; bj < 2; ++bj) { const f32x4 v0 = acc[ai][bj][m][0], v1 = acc[ai][bj][m][1];
                        u32x4 w; w.x = cvt_pk_bf16(v0[0], v0[1]); w.y = cvt_pk_bf16(v0[2], v0[3]); w.z = cvt_pk_bf16(v1[0], v1[1]); w.w = cvt_pk_bf16(v1[2], v1[3]);
                        *(u32x4*)(rowp + bj * HALF) = w; } }
        } else if (wc == 0) {
#pragma unroll
            for (int ai = 0; ai < 2; ++ai)
#pragma unroll
                for (int m = 0; m < 4; ++m) { float* rowp = AB + (size_t)(row0 + ai * HALF + m * 16) * 32 + 8 * fq;
                    *(f32x4*)(rowp) = acc[ai][0][m][0]; *(f32x4*)(rowp + 4) = acc[ai][0][m][1]; }
        }
    }
};


template <class Epi, class Sched, bool ALIGN_EPI = true, bool SP2 = true>
__device__ __forceinline__ void gemm_phase(PG8_LAS unsigned char* lds, const Gemm g, const Sched& S, const Epi& E, int wv) {
    const int tid = opaque_tid(wv), wid = __builtin_amdgcn_readfirstlane(tid >> 6), lane = tid & 63, wr = wid >> 2, wc = wid & 3, fr = lane & 15, fq = lane >> 4;
    const int K = g.K, nt = K / BK;
    unsigned voffA[2], voffB[2];
#pragma unroll
    for (int i = 0; i < 2; ++i) { int R, C; stage_rc(tid * 16 + i * 8192, R, C); const int Rb = Epi::PERM ? ((R & ~31) + perm32(R & 31)) : R;
        voffA[i] = (unsigned)(R * K + C) * 2u; voffB[i] = (unsigned)(Rb * K + C) * 2u; }
    const size_t kstep = (size_t)(BK * 2);
    const size_t hstep = (size_t)HALF * K * 2;
    const size_t tstep = 2 * hstep;
    const unsigned ldsw = (unsigned)wid * 1024u;
    const int aoff = lds_byte(wr * 64 + fr, fq * 8), boff = lds_byte(wc * 32 + fr, fq * 8);
#define PG8_SA(b, h) (((b) * 2 + (h)) * HTB)
#define PG8_SB(b, h) ((4 + (b) * 2 + (h)) * HTB)
#define PG8_STAGE(bufoff, gbase, voff) do { _Pragma("unroll") for (int _i = 0; _i < 2; ++_i) \
        __builtin_amdgcn_global_load_lds((const unsigned*)((const char*)(gbase) + (voff)[_i]), (PG8_LAS unsigned*)(lds + (bufoff) + ldsw + _i * 8192), 16, 0, 0); } while (0)
#define PG8_LDA(dst, b, h) do { _Pragma("unroll") for (int m = 0; m < 4; ++m) _Pragma("unroll") for (int k = 0; k < 2; ++k) dst[m][k] = *(const PG8_LAS bf16x8*)(lds + PG8_SA(b, h) + aoff + m * 2048 + k * 1024); } while (0)
#define PG8_LDB(dst, b, h) do { _Pragma("unroll") for (int n = 0; n < 2; ++n) _Pragma("unroll") for (int k = 0; k < 2; ++k) dst[n][k] = *(const PG8_LAS bf16x8*)(lds + PG8_SB(b, h) + boff + n * 2048 + k * 1024); } while (0)
#define PG8_MMA(ai, bj, At, Bt) do { __builtin_amdgcn_s_setprio(1); _Pragma("unroll") for (int m = 0; m < 4; ++m) _Pragma("unroll") for (int n = 0; n < 2; ++n) _Pragma("unroll") for (int k = 0; k < 2; ++k) \
        acc[ai][bj][m][n] = __builtin_amdgcn_mfma_f32_16x16x32_bf16(Bt[n][k], At[m][k], acc[ai][bj][m][n], 0, 0, 0); __builtin_amdgcn_s_setprio(0); } while (0)
#define PG8_WAIT_V(n) asm volatile("s_waitcnt vmcnt(" #n ")" ::: "memory")
#define PG8_WAIT_L(n) asm volatile("s_waitcnt lgkmcnt(" #n ")" ::: "memory")
#define PG8_BAR __builtin_amdgcn_s_barrier()
#define PG8_SCHED __builtin_amdgcn_sched_barrier(0)
    Unit cur, nxt; int ui = 0;
    if (!S.next(0, cur)) return;
    f32x4 acc[2][2][4][2];
#pragma unroll
    for (int a = 0; a < 2; ++a)
#pragma unroll
        for (int b = 0; b < 2; ++b)
#pragma unroll
            for (int m = 0; m < 4; ++m)
#pragma unroll
                for (int n = 0; n < 2; ++n) acc[a][b][m][n] = (f32x4){0.f, 0.f, 0.f, 0.f};
    bf16x8 At[4][2], B0[2][2], B1[2][2];
    const char* cA = (const char*)g.A + (size_t)cur.pm * tstep; const char* cB = (const char*)g.Bt + (size_t)cur.pn * tstep;
    S.a_ready(cur);
    if constexpr (SP2) {
        PG8_STAGE(PG8_SB(0, 0), cB, voffB); PG8_STAGE(PG8_SB(0, 1), cB + hstep, voffB); PG8_STAGE(PG8_SA(0, 0), cA, voffA); PG8_STAGE(PG8_SA(0, 1), cA + hstep, voffA);
        if (wr == 1) PG8_BAR;
        PG8_WAIT_V(2); PG8_BAR;
        PG8_STAGE(PG8_SB(1, 0), cB + kstep, voffB); PG8_STAGE(PG8_SA(1, 0), cA + kstep, voffA); PG8_STAGE(PG8_SB(1, 1), cB + hstep + kstep, voffB);
        PG8_WAIT_V(6); PG8_BAR;
    } else {
        PG8_STAGE(PG8_SB(0, 0), cB, voffB); PG8_STAGE(PG8_SA(0, 0), cA, voffA); PG8_STAGE(PG8_SB(0, 1), cB + hstep, voffB); PG8_STAGE(PG8_SA(0, 1), cA + hstep, voffA);
        if (wr == 1) PG8_BAR;
        PG8_WAIT_V(4); PG8_BAR;
        PG8_STAGE(PG8_SB(1, 0), cB + kstep, voffB); PG8_STAGE(PG8_SA(1, 0), cA + kstep, voffA); PG8_STAGE(PG8_SB(1, 1), cB + hstep + kstep, voffB);
        PG8_WAIT_V(6); PG8_BAR;
    }
    for (;;) {
        const bool has_next = S.next(ui + 1, nxt);
        const char* nA = has_next ? (const char*)g.A + (size_t)nxt.pm * tstep : cA; const char* nB = has_next ? (const char*)g.Bt + (size_t)nxt.pn * tstep : cB;
        for (int t = 0; t < nt; t += 2) {
            const bool last = (t == nt - 2);
            const char* a1 = cA + (size_t)(t + 1) * kstep;
            const char* a2 = last ? nA : cA + (size_t)(t + 2) * kstep; const char* b2 = last ? nB : cB + (size_t)(t + 2) * kstep;
            const char* a3 = a2 + kstep; const char* b3 = b2 + kstep;
            if (last && has_next) S.a_ready(nxt);
            if constexpr (SP2) {
            PG8_LDB(B0, 0, 0); PG8_LDB(B1, 0, 1); PG8_SCHED; PG8_LDA(At, 0, 0); PG8_STAGE(PG8_SA(1, 1), a1 + hstep, voffA);
            PG8_WAIT_V(8); PG8_WAIT_L(0); PG8_BAR; PG8_MMA(0, 0, At, B0); PG8_MMA(0, 1, At, B1); PG8_BAR; PG8_SCHED;
            PG8_LDA(At, 0, 1); PG8_STAGE(PG8_SB(0, 0), b2, voffB); PG8_STAGE(PG8_SB(0, 1), b2 + hstep, voffB); PG8_STAGE(PG8_SA(0, 0), a2, voffA);
            PG8_WAIT_V(8); PG8_WAIT_L(0); PG8_BAR; PG8_MMA(1, 0, At, B0); PG8_MMA(1, 1, At, B1); PG8_BAR; PG8_SCHED;
            PG8_LDB(B0, 1, 0); PG8_LDB(B1, 1, 1); PG8_SCHED; PG8_LDA(At, 1, 0); PG8_STAGE(PG8_SA(0, 1), a2 + hstep, voffA);
            PG8_WAIT_V(8); PG8_WAIT_L(0); PG8_BAR; PG8_MMA(0, 0, At, B0); PG8_MMA(0, 1, At, B1); PG8_BAR; PG8_SCHED;
            PG8_LDA(At, 1, 1); PG8_STAGE(PG8_SB(1, 0), b3, voffB); PG8_STAGE(PG8_SB(1, 1), b3 + hstep, voffB); PG8_STAGE(PG8_SA(1, 0), a3, voffA);
            PG8_WAIT_V(8); PG8_WAIT_L(0); PG8_BAR; PG8_MMA(1, 0, At, B0); PG8_MMA(1, 1, At, B1); PG8_BAR; PG8_SCHED;
            } else {
            PG8_LDB(B0, 0, 0); PG8_SCHED; PG8_LDA(At, 0, 0); PG8_STAGE(PG8_SA(1, 1), a1 + hstep, voffA);
            PG8_WAIT_L(8); PG8_BAR; PG8_WAIT_L(0); PG8_MMA(0, 0, At, B0); PG8_BAR; PG8_SCHED;
            PG8_LDB(B1, 0, 1); PG8_STAGE(PG8_SB(0, 0), b2, voffB);
            PG8_BAR; PG8_WAIT_L(0); PG8_MMA(0, 1, At, B1); PG8_BAR;
            PG8_LDA(At, 0, 1); PG8_STAGE(PG8_SA(0, 0), a2, voffA);
            PG8_BAR; PG8_WAIT_L(0); PG8_MMA(1, 0, At, B0); PG8_BAR; PG8_SCHED;
            PG8_STAGE(PG8_SB(0, 1), b2 + hstep, voffB);
            PG8_WAIT_V(6); PG8_BAR; PG8_MMA(1, 1, At, B1); PG8_BAR;
            PG8_LDB(B0, 1, 0); PG8_SCHED; PG8_LDA(At, 1, 0); PG8_STAGE(PG8_SA(0, 1), a2 + hstep, voffA);
            PG8_WAIT_L(8); PG8_BAR; PG8_WAIT_L(0); PG8_MMA(0, 0, At, B0); PG8_BAR; PG8_SCHED;
            PG8_LDB(B1, 1, 1); PG8_STAGE(PG8_SB(1, 0), b3, voffB);
            PG8_BAR; PG8_WAIT_L(0); PG8_MMA(0, 1, At, B1); PG8_BAR;
            PG8_LDA(At, 1, 1); PG8_STAGE(PG8_SA(1, 0), a3, voffA);
            PG8_BAR; PG8_WAIT_L(0); PG8_MMA(1, 0, At, B0); PG8_BAR; PG8_SCHED;
            PG8_STAGE(PG8_SB(1, 1), b3 + hstep, voffB);
            PG8_WAIT_V(6); PG8_BAR; PG8_MMA(1, 1, At, B1); PG8_BAR;
            }
        }
        if constexpr (ALIGN_EPI) { if (wr == 0) PG8_BAR; }
        if constexpr (!Epi::AFTER_DRAIN) { E(acc, cur, wr, wc, fr, fq); S.done(cur); }
        if (!has_next) break;
#pragma unroll
        for (int a = 0; a < 2; ++a)
#pragma unroll
            for (int b = 0; b < 2; ++b)
#pragma unroll
                for (int m = 0; m < 4; ++m)
#pragma unroll
                    for (int n = 0; n < 2; ++n) acc[a][b][m][n] = (f32x4){0.f, 0.f, 0.f, 0.f};
        cur = nxt; cA = nA; cB = nB; ++ui;
        if constexpr (ALIGN_EPI) { if (wr == 1) PG8_BAR; }
    }
    PG8_WAIT_V(0);
    if constexpr (!ALIGN_EPI) { if (wr == 0) PG8_BAR; }
    PG8_BAR;
    if constexpr (Epi::AFTER_DRAIN) { E.fused(acc, cur, wr, wc, fr, fq, lds, wid, lane); S.done(cur); }
#undef PG8_SA
#undef PG8_SB
#undef PG8_STAGE
#undef PG8_LDA
#undef PG8_LDB
#undef PG8_MMA
#undef PG8_WAIT_V
#undef PG8_WAIT_L
#undef PG8_BAR
#undef PG8_SCHED
}
}

namespace att {
constexpr int D = 128, NW = 8, QBLK = 32, KVBLK = 64;
constexpr float SCALE = 0.088388347648318440f;
constexpr size_t SHM_V = KVBLK * D * 2, SHM_K = KVBLK * D * 2, VSL = 2 * SHM_V, SHM_ATTN = 2 * VSL + 2 * SHM_K + NW * 64 * 4;
using bf16x8 = __attribute__((ext_vector_type(8))) short;
using s16x4  = __attribute__((ext_vector_type(4))) short;
using f32x16 = __attribute__((ext_vector_type(16))) float;
using u32x4  = __attribute__((ext_vector_type(4))) unsigned;
#define KSWZ(row, colB) ((row) * 256 + ((colB) ^ (((row) & 7) << 4)))
#define SBAR() __builtin_amdgcn_sched_barrier(0)
__device__ __forceinline__ int crow(int r, int hi) { return (r & 3) + 8 * (r >> 2) + 4 * hi; }
__device__ __forceinline__ unsigned cvtpk(float lo, float hi) {
  unsigned r; asm volatile("v_cvt_pk_bf16_f32 %0, %1, %2" : "=v"(r) : "v"(lo), "v"(hi)); return r;
}
__device__ __forceinline__ void partialSM(f32x16& p0, f32x16& p1, float mnC, bool shift) {
  if (shift) {
#pragma unroll
    for (int r = 0; r < 16; ++r) { p0[r] += mnC; p1[r] += mnC; } }
#pragma unroll
  for (int r = 0; r < 16; ++r) p0[r] = __builtin_amdgcn_exp2f(p0[r]);
}
__device__ __forceinline__ void finishSM(f32x16& p0, f32x16& p1, float& l_reg, bf16x8& pa0, bf16x8& pa1, bf16x8& pa2, bf16x8& pa3) {
#pragma unroll
  for (int r = 0; r < 16; ++r) p1[r] = __builtin_amdgcn_exp2f(p1[r]);
  float ps = 0;
#pragma unroll
  for (int r = 0; r < 16; ++r) ps += p0[r];
#pragma unroll
  for (int r = 0; r < 16; ++r) ps += p1[r];
  { auto rr = __builtin_amdgcn_permlane32_swap(__float_as_uint(ps), __float_as_uint(ps), false, false);
    ps = __uint_as_float(rr[0]) + __uint_as_float(rr[1]); }
  l_reg += ps;
#define PK4(P, BASE, OUT) do { unsigned a0 = cvtpk(P[BASE + 0], P[BASE + 1]), a1 = cvtpk(P[BASE + 2], P[BASE + 3]);   \
    unsigned b0 = cvtpk(P[BASE + 4], P[BASE + 5]), b1 = cvtpk(P[BASE + 6], P[BASE + 7]);                              \
    auto r0 = __builtin_amdgcn_permlane32_swap(a0, b0, false, false); auto r1 = __builtin_amdgcn_permlane32_swap(a1, b1, false, false); \
    u32x4 w = {r0[0], r1[0], r0[1], r1[1]}; OUT = *reinterpret_cast<bf16x8*>(&w); } while (0)
  PK4(p0, 0, pa0); PK4(p0, 8, pa1); PK4(p1, 0, pa2); PK4(p1, 8, pa3);
#undef PK4
}
__device__ __forceinline__ void qkt(f32x16& p0, f32x16& p1, const bf16_t* Ks, const bf16x8* qr, int r32, int hi) {
  p0 = f32x16{}; p1 = f32x16{};
#pragma unroll
  for (int d0 = 0; d0 < 8; ++d0) { int cb = (d0 * 16 + hi * 8) * 2;
    bf16x8 b0 = *reinterpret_cast<const bf16x8*>((const char*)Ks + KSWZ(r32, cb));
    bf16x8 b1 = *reinterpret_cast<const bf16x8*>((const char*)Ks + KSWZ(32 + r32, cb));
    p0 = __builtin_amdgcn_mfma_f32_32x32x16_bf16(b0, qr[d0], p0, 0, 0, 0);
    p1 = __builtin_amdgcn_mfma_f32_32x32x16_bf16(b1, qr[d0], p1, 0, 0, 0); }
}
__device__ __forceinline__ int v_st(int k, int c) { const int kk = (k & ~0xC) | ((k & 4) << 1) | ((k & 8) >> 1); return ((kk >> 3) * 4 + (c >> 5)) * 512 + ((kk & 7) * 32 + (c & 31)) * 2; }
__device__ __forceinline__ int v_rd_base(int lane) { return ((lane & 3) << 3) | (((lane >> 2) & 3) << 6) | (((lane >> 4) & 1) << 5) | (((lane >> 5) & 1) << 8); }
constexpr int v_rd_off(int d0, int ks, int half) { return d0 * 512 + ks * 4096 + half * 2048; }
template <int OFF> __device__ __forceinline__ s16x4 tr_read(int vb) {
  s16x4 r; asm volatile("ds_read_b64_tr_b16 %0, %1 offset:%2" : "=&v"(r) : "v"(vb), "i"(OFF) : "memory"); return r;
}
template <int D0> __device__ __forceinline__ void pv_one(f32x16& od, int vb, bf16x8 pa0, bf16x8 pa1, bf16x8 pa2, bf16x8 pa3) {
  const s16x4 l0 = tr_read<v_rd_off(D0, 0, 0)>(vb), h0 = tr_read<v_rd_off(D0, 0, 1)>(vb), l1 = tr_read<v_rd_off(D0, 1, 0)>(vb), h1 = tr_read<v_rd_off(D0, 1, 1)>(vb);
  const s16x4 l2 = tr_read<v_rd_off(D0, 2, 0)>(vb), h2 = tr_read<v_rd_off(D0, 2, 1)>(vb), l3 = tr_read<v_rd_off(D0, 3, 0)>(vb), h3 = tr_read<v_rd_off(D0, 3, 1)>(vb);
  asm volatile("s_waitcnt lgkmcnt(0)" ::: "memory"); SBAR();
#define PK(L, H) (bf16x8){L[0], L[1], L[2], L[3], H[0], H[1], H[2], H[3]}
  od = __builtin_amdgcn_mfma_f32_32x32x16_bf16(pa0, PK(l0, h0), od, 0, 0, 0);
  od = __builtin_amdgcn_mfma_f32_32x32x16_bf16(pa1, PK(l1, h1), od, 0, 0, 0);
  od = __builtin_amdgcn_mfma_f32_32x32x16_bf16(pa2, PK(l2, h2), od, 0, 0, 0);
  od = __builtin_amdgcn_mfma_f32_32x32x16_bf16(pa3, PK(l3, h3), od, 0, 0, 0);
#undef PK
}
__device__ __forceinline__ void pv_d0(f32x16* o, int vb, bf16x8 pa0, bf16x8 pa1, bf16x8 pa2, bf16x8 pa3) {
  pv_one<0>(o[0], vb, pa0, pa1, pa2, pa3); pv_one<1>(o[1], vb, pa0, pa1, pa2, pa3); pv_one<2>(o[2], vb, pa0, pa1, pa2, pa3); pv_one<3>(o[3], vb, pa0, pa1, pa2, pa3);
}

__device__ __forceinline__ bf16x8 ldb128(__amdgpu_buffer_rsrc_t r, unsigned voff, unsigned soff) {
  u32x4 v = __builtin_amdgcn_raw_buffer_load_b128(r, (int)voff, (int)soff, 0); return *reinterpret_cast<bf16x8*>(&v);
}
typedef LAS const char* lds_cptr;
typedef short v4i16_t __attribute__((ext_vector_type(4)));
typedef unsigned u32x2_t __attribute__((ext_vector_type(2)));
#define PIN(x) asm volatile("" : "+v"(x))
#define MFMA32(a, b, c) __builtin_amdgcn_mfma_f32_32x32x16_bf16((a), (b), (c), 0, 0, 0)
__device__ __forceinline__ s16x4 vtr(lds_cptr p) { return __builtin_bit_cast(s16x4, __builtin_amdgcn_ds_read_tr16_b64_v4i16((LAS v4i16_t*)p)); }
__device__ __forceinline__ bf16x8 kfrag(const lds_cptr (&kp)[8], int g, int ks) { return *(const LAS bf16x8*)(kp[g >> 1] + (ks + (g & 1) * 8192)); }
__device__ __forceinline__ void vfrag(s16x4& lo, s16x4& hi, lds_cptr vp, int g, int vs) { lo = vtr(vp + (vs + (g & 3) * 512 + (g >> 2) * 4096)); hi = vtr(vp + (vs + (g & 3) * 512 + (g >> 2) * 4096 + 2048)); }
template <bool SH> __device__ __forceinline__ float ex2(float v, float nm) { return __builtin_amdgcn_exp2f(SH ? v + nm : v); }
constexpr int FW = 6;
template <int NV, int F, int KS, int VS> __device__ __forceinline__ u32x4 mfrag(lds_cptr vp, const lds_cptr (&kp)[8]) {
  if constexpr (F < 16 * NV) { s16x4 lo, hi; vfrag(lo, hi, vp, F & 15, VS + (F >> 4) * (int)SHM_V); const u32x2_t a = __builtin_bit_cast(u32x2_t, lo), b = __builtin_bit_cast(u32x2_t, hi); return (u32x4){a[0], a[1], b[0], b[1]}; }
  else return __builtin_bit_cast(u32x4, kfrag(kp, F - 16 * NV, KS));
}
template <int NV, int G, int NG, int F0, int KS, int VS> __device__ __forceinline__ void gapM(f32x16 (&o)[4 * NV], const u32x4 (&pw)[4], f32x16& C0, f32x16& C1, const bf16x8 (&qr)[8], u32x4 (&fw)[FW],
    lds_cptr vp, const lds_cptr (&kp)[8]) {
  if constexpr (G + FW - 1 < NG) fw[(G + FW - 1) % FW] = mfrag<NV, F0 + G + FW - 1, KS, VS>(vp, kp);
  constexpr int F = F0 + G;
  if constexpr (F < 16 * NV) o[(F >> 4) * 4 + (F & 3)] = MFMA32(__builtin_bit_cast(bf16x8, pw[(F & 15) >> 2]), __builtin_bit_cast(bf16x8, fw[G % FW]), o[(F >> 4) * 4 + (F & 3)]);
  else { constexpr int g = F - 16 * NV;
    if constexpr ((g & 1) == 0) { if constexpr (g < 2) C0 = MFMA32(__builtin_bit_cast(bf16x8, fw[G % FW]), qr[g >> 1], f32x16{}); else C0 = MFMA32(__builtin_bit_cast(bf16x8, fw[G % FW]), qr[g >> 1], C0); }
    else { if constexpr (g < 2) C1 = MFMA32(__builtin_bit_cast(bf16x8, fw[G % FW]), qr[g >> 1], f32x16{}); else C1 = MFMA32(__builtin_bit_cast(bf16x8, fw[G % FW]), qr[g >> 1], C1); } }
  SBAR();
}
template <int NV, int G, int NG, int F0, int KS, int VS> struct MSeg {
  static __device__ __forceinline__ void run(f32x16 (&o)[4 * NV], const u32x4 (&pw)[4], f32x16& C0, f32x16& C1, const bf16x8 (&qr)[8], u32x4 (&fw)[FW], lds_cptr vp, const lds_cptr (&kp)[8]) {
    if constexpr (G == 0) {
      fw[0] = mfrag<NV, F0 + 0, KS, VS>(vp, kp); fw[1] = mfrag<NV, F0 + 1, KS, VS>(vp, kp); fw[2] = mfrag<NV, F0 + 2, KS, VS>(vp, kp); fw[3] = mfrag<NV, F0 + 3, KS, VS>(vp, kp); fw[4] = mfrag<NV, F0 + 4, KS, VS>(vp, kp);
      static_assert(FW == 6, "prefetch list"); SBAR(); }
    gapM<NV, G, NG, F0, KS, VS>(o, pw, C0, C1, qr, fw, vp, kp);
    if constexpr (G + 1 < NG) MSeg<NV, G + 1, NG, F0, KS, VS>::run(o, pw, C0, C1, qr, fw, vp, kp);
  }
};
__device__ __forceinline__ void dma16(u32x4 rsrc, unsigned voff, unsigned soff, unsigned lds_addr) {
  unsigned sv; asm volatile("s_mov_b32 %0, m0\n\ts_mov_b32 m0, %4\n\ts_nop 0\n\tbuffer_load_dwordx4 %1, %2, %3 offen lds\n\ts_mov_b32 m0, %0" : "=&s"(sv) : "v"(voff), "s"(rsrc), "s"(soff), "s"(lds_addr) : "memory"); }
struct Unit {
  const bf16_t* Q; const bf16_t* K1; const bf16_t* V1; const bf16_t* K2; const bf16_t* V2; bf16_t* O; const bf16_t* G;
  const float* qw;
  const float* rope;
  const float* kp;
  float kcm;
  int ldq, ld1, n1, ld2, n2, ldo, ldg, t0;
};
template <int NV> __device__ __forceinline__ void attn_unit(const Unit& U, char* lds, int wv) {
  const int tid = opaque_tid(wv), wid = wv, lane = tid & 63, r32 = lane & 31, hi = lane >> 5;
  bf16_t* V_lds = (bf16_t*)lds; bf16_t* K_lds = (bf16_t*)(lds + 2 * VSL);
  float* ws = (float*)(lds + 2 * VSL + 2 * SHM_K) + wid * 64; float* li_l = ws;
  float l_reg = 0, mnC; f32x16 o[4 * NV] = {}; bf16x8 qr[8];
  const bf16_t* Qw = U.Q + (long)(wid * QBLK + r32) * U.ldq + hi * 8;
#pragma unroll
  for (int d0 = 0; d0 < 8; ++d0) qr[d0] = *reinterpret_cast<const bf16x8*>(Qw + d0 * 16);
  const int vb0 = (int)(uintptr_t)V_lds + v_rd_base(lane);
  const int n1 = U.n1;
  const unsigned krow = (unsigned)(wv * 8 + (lane >> 4)), kc16 = (unsigned)(((lane & 15) ^ ((wv & 1) * 8 + (lane >> 4))) << 4);
  const unsigned vkk = (unsigned)(wv * 8 + ((lane & 31) >> 2)), vrow = vkk, vcb = (unsigned)((lane >> 5) * 64 + (lane & 3) * 16);
  const unsigned kdst = (unsigned)(uintptr_t)K_lds + (unsigned)wv * 2048u, vdst = (unsigned)(uintptr_t)V_lds + (unsigned)wv * 2048u;
#define BSYNC() do { SBAR(); __syncthreads(); SBAR(); } while (0)
#define DSYNC() do { SBAR(); asm volatile("s_waitcnt vmcnt(0)" ::: "memory"); __syncthreads(); SBAR(); } while (0)
#define RSRC(p) (u32x4){(unsigned)(uintptr_t)(p), (unsigned)((uintptr_t)(p) >> 32) & 0xffffu, 0x7fffffffu, 0x00020000u}
#define DMA_K(t, slot) do { const int _k0 = (t) * KVBLK; const bool _s1 = _k0 < n1; const u32x4 _r = RSRC(_s1 ? U.K1 : U.K2);                                  \
    const unsigned _ldb = (unsigned)(_s1 ? U.ld1 : U.ld2) * 2u, _so = (unsigned)(_s1 ? _k0 : _k0 - n1) * _ldb, _v = krow * _ldb + kc16;  \
    dma16(_r, _v, _so, kdst + (slot) * (unsigned)SHM_K); dma16(_r, _v ^ 64u, _so + 4u * _ldb, kdst + (slot) * (unsigned)SHM_K + 1024u); } while (0)
#define DMA_V(t, slot) do { const int _k0 = (t) * KVBLK; const bool _s1 = _k0 < n1; const u32x4 _r = RSRC(_s1 ? U.V1 : U.V2);                                  \
    const unsigned _ldb = (unsigned)(_s1 ? U.ld1 : U.ld2) * 2u, _so = (unsigned)(_s1 ? _k0 : _k0 - n1) * _ldb, _v = vrow * _ldb + vcb;   \
    _Pragma("unroll") for (unsigned _j = 0; _j < (unsigned)NV; ++_j) { dma16(_r, _v + _j * 256u, _so, vdst + (slot) * (unsigned)VSL + _j * (unsigned)SHM_V);        \
      dma16(_r, _v + _j * 256u + 128u, _so, vdst + (slot) * (unsigned)VSL + _j * (unsigned)SHM_V + 1024u); } } while (0)
  const unsigned k4v = (unsigned)((wv & 3) * 16 + (lane >> 4)), k4c = (unsigned)(((lane & 15) ^ (lane >> 4)) << 4), v4v = (unsigned)((wv & 3) * 16 + ((lane & 31) >> 2));
  const unsigned k4dst = (unsigned)(uintptr_t)K_lds + (unsigned)(wv & 3) * 4096u, v4dst = (unsigned)(uintptr_t)V_lds + (unsigned)(wv & 3) * 4096u;
#define DMA4_K(t, slot) do { const int _k0 = (t) * KVBLK; const bool _s1 = _k0 < n1; const u32x4 _r = RSRC(_s1 ? U.K1 : U.K2);                                 \
    const unsigned _ldb = (unsigned)(_s1 ? U.ld1 : U.ld2) * 2u, _so = (unsigned)(_s1 ? _k0 : _k0 - n1) * _ldb, _v = k4v * _ldb + k4c;    \
    _Pragma("unroll") for (unsigned _n = 0; _n < 4; ++_n) dma16(_r, _v ^ (_n << 6), _so + 4u * _n * _ldb, k4dst + (slot) * (unsigned)SHM_K + _n * 1024u); } while (0)
#define DMA4_V(t, slot) do { const int _k0 = (t) * KVBLK; const bool _s1 = _k0 < n1; const u32x4 _r = RSRC(_s1 ? U.V1 : U.V2);                                 \
    const unsigned _ldb = (unsigned)(_s1 ? U.ld1 : U.ld2) * 2u, _so = (unsigned)(_s1 ? _k0 : _k0 - n1) * _ldb, _v = v4v * _ldb + vcb;     \
    _Pragma("unroll") for (unsigned _j = 0; _j < (unsigned)NV; ++_j) _Pragma("unroll") for (unsigned _g = 0; _g < 2; ++_g) _Pragma("unroll") for (unsigned _n = 0; _n < 2; ++_n)  \
      dma16(_r, _v + _j * 256u + _n * 128u, _so + 8u * _g * _ldb, v4dst + (slot) * (unsigned)VSL + _j * (unsigned)SHM_V + _g * 2048u + _n * 1024u); } while (0)
  DMA_K(0, 0); DMA_V(0, 0); DMA_K(1, 1);
  {
    float x[8][8];
#pragma unroll
    for (int d0 = 0; d0 < 8; ++d0) { const u32x4 w = *reinterpret_cast<const u32x4*>(&qr[d0]);
#pragma unroll
      for (int e = 0; e < 4; ++e) { x[d0][2 * e] = __uint_as_float(w[e] << 16); x[d0][2 * e + 1] = __uint_as_float(w[e] & 0xffff0000u); } }
    if (U.qw) { float ss = 0.f;
#pragma unroll
      for (int d0 = 0; d0 < 8; ++d0)
#pragma unroll
        for (int e = 0; e < 8; ++e) ss += x[d0][e] * x[d0][e];
      { auto rr = __builtin_amdgcn_permlane32_swap(__float_as_uint(ss), __float_as_uint(ss), false, false); ss = __uint_as_float(rr[0]) + __uint_as_float(rr[1]); }
      const float rn = rsqrtf(ss * (1.0f / 128.0f) + 1e-6f);
#pragma unroll
      for (int d0 = 0; d0 < 8; ++d0) { const float4 w0 = *(const float4*)(U.qw + d0 * 16 + hi * 8), w1 = *(const float4*)(U.qw + d0 * 16 + hi * 8 + 4);
        x[d0][0] *= rn * w0.x; x[d0][1] *= rn * w0.y; x[d0][2] *= rn * w0.z; x[d0][3] *= rn * w0.w; x[d0][4] *= rn * w1.x; x[d0][5] *= rn * w1.y; x[d0][6] *= rn * w1.z; x[d0][7] *= rn * w1.w;
        if (d0 & 1) SBAR(); } }
    if (U.rope) { const int t = U.t0 + wid * QBLK + r32;
#pragma unroll
      for (int a = 0; a < 2; ++a) { const int pos = a ? (t & 63) : (t >> 6);
#pragma unroll
        for (int dd = 0; dd < 2; ++dd) { const int d0 = a * 4 + dd; const float* cp = U.rope + pos * 32 + dd * 16 + hi * 8;
          const float4 c0 = *(const float4*)cp, c1 = *(const float4*)(cp + 4), s0 = *(const float4*)(cp + 2048), s1 = *(const float4*)(cp + 2048 + 4);
          const float cs[8] = {c0.x, c0.y, c0.z, c0.w, c1.x, c1.y, c1.z, c1.w}, sn[8] = {s0.x, s0.y, s0.z, s0.w, s1.x, s1.y, s1.z, s1.w};
#pragma unroll
          for (int e = 0; e < 8; ++e) { const float x1 = x[d0][e], x2 = x[d0 + 2][e]; x[d0][e] = x1 * cs[e] - x2 * sn[e]; x[d0 + 2][e] = x2 * cs[e] + x1 * sn[e]; }
          SBAR(); } } }
    float sq = 0.f;
#pragma unroll
    for (int d0 = 0; d0 < 8; ++d0)
#pragma unroll
      for (int e = 0; e < 8; ++e) sq += x[d0][e] * x[d0][e];
    { auto rr = __builtin_amdgcn_permlane32_swap(__float_as_uint(sq), __float_as_uint(sq), false, false); sq = __uint_as_float(rr[0]) + __uint_as_float(rr[1]); }
    float km = 0.f;
    for (int j = lane; j < (int)gridDim.x; j += 64) km = fmaxf(km, U.kp[(size_t)j * KP_STRIDE]);
    { int ll = lane; asm volatile("" : "+v"(ll));
#pragma unroll
      for (int o2 = 32; o2 >= 1; o2 >>= 1) km = fmaxf(km, shfl_xor_at(km, o2, ll)); }
    km = fmaxf(km, U.kcm);
    mnC = -(sqrtf(sq) * km * 1.02f) * (SCALE * 1.4426950408889634f);
#pragma unroll
    for (int d0 = 0; d0 < 8; ++d0)
#pragma unroll
      for (int e = 0; e < 8; ++e) x[d0][e] *= (SCALE * 1.4426950408889634f);
#pragma unroll
    for (int d0 = 0; d0 < 8; ++d0) { u32x4 w = {cvt_pk_rn(x[d0][0], x[d0][1]), cvt_pk_rn(x[d0][2], x[d0][3]), cvt_pk_rn(x[d0][4], x[d0][5]), cvt_pk_rn(x[d0][6], x[d0][7])}; qr[d0] = *reinterpret_cast<bf16x8*>(&w); }
  }
  f32x16 C0, C1; const int NT = (U.n1 + U.n2) / KVBLK;
  u32x4 fw[FW]; u32x4 pw[4];
  lds_cptr kp[8]; const lds_cptr vp = (lds_cptr)(unsigned)vb0;
  { const unsigned s = (unsigned)r32 & 15u, kb = (unsigned)(uintptr_t)K_lds + (unsigned)r32 * 256u;
#pragma unroll
    for (int j = 0; j < 8; ++j) kp[j] = (lds_cptr)(kb + ((((unsigned)j * 2u + (unsigned)hi) ^ s) << 4)); }
  const bool shift = __any(mnC < -100.f);
  const int role = wv >> 2;
#define VS_TAIL() do { float sacc = 0.f;                                                                                                          \
    _Pragma("unroll") for (int r = 0; r < 16; ++r) { C0[r] = __builtin_amdgcn_exp2f(C0[r]); sacc += C0[r]; }                                  \
    _Pragma("unroll") for (int r = 0; r < 16; ++r) { C1[r] = __builtin_amdgcn_exp2f(C1[r]); sacc += C1[r]; }                                  \
    l_reg += sacc; PIN(l_reg);                                            \
    _Pragma("unroll") for (int m = 0; m < 4; ++m) _Pragma("unroll") for (int i = 0; i < 4; ++i) { const int e = 8 * (m & 1) + 2 * i;          \
        pw[m][i] = (m >> 1) ? cvt_pk_rn(C1[e], C1[e + 1]) : cvt_pk_rn(C0[e], C0[e + 1]); } } while (0)
#define VSEG(t, FIRST) do { const int _s = (t) + 1;                                                                                           \
    if (role) { if (_s + 1 < NT) { if (_s & 1) DMA4_K(_s + 1, 0); else DMA4_K(_s + 1, 1); }                                                   \
                if (_s < NT) { if (_s & 1) DMA4_V(_s, 1); else DMA4_V(_s, 0); } }                                                             \
    if (FIRST) {                         \
      if (shift) { float pmax = C0[0];                        \
        _Pragma("unroll") for (int r = 1; r < 16; ++r) pmax = fmaxf(pmax, C0[r]);                                                             \
        _Pragma("unroll") for (int r = 0; r < 16; ++r) pmax = fmaxf(pmax, C1[r]);                                                             \
        { auto rr = __builtin_amdgcn_permlane32_swap(__float_as_uint(pmax), __float_as_uint(pmax), false, false); pmax = fmaxf(__uint_as_float(rr[0]), __uint_as_float(rr[1])); } \
        mnC = -fminf(-mnC, pmax + 57.7f); } else mnC = 0.f; }                                                                                 \
      \
    if (shift) { _Pragma("unroll") for (int r = 0; r < 16; ++r) { C0[r] += mnC; C1[r] += mnC; } VS_TAIL(); } else { VS_TAIL(); }                \
    } while (0)
  DSYNC();
  if (role) DSYNC();
  MSeg<NV, 0, 16, 16 * NV, 0, 0>::run(o, pw, C0, C1, qr, fw, vp, kp);
  DSYNC(); VSEG(0, true); BSYNC();
  for (int t = 1; t + 1 < NT; t += 2) {
    MSeg<NV, 0, 16 * NV + 16, 0, (int)SHM_K, 0>::run(o, pw, C0, C1, qr, fw, vp, kp);
    DSYNC(); VSEG(t, false); BSYNC();
    MSeg<NV, 0, 16 * NV + 16, 0, 0, (int)VSL>::run(o, pw, C0, C1, qr, fw, vp, kp);
    DSYNC(); VSEG(t + 1, false); BSYNC();
  }
  MSeg<NV, 0, 16 * NV + 16, 0, (int)SHM_K, 0>::run(o, pw, C0, C1, qr, fw, vp, kp);
  DSYNC(); VSEG(NT - 1, false); BSYNC();
  MSeg<NV, 0, 16 * NV, 0, 0, (int)VSL>::run(o, pw, C0, C1, qr, fw, vp, kp);
  if (!role) DSYNC();
#undef VSEG
#undef VS_TAIL
  { auto rr = __builtin_amdgcn_permlane32_swap(__float_as_uint(l_reg), __float_as_uint(l_reg), false, false); l_reg = __uint_as_float(rr[0]) + __uint_as_float(rr[1]); }
  if (hi == 0) li_l[r32] = l_reg; asm volatile("s_waitcnt lgkmcnt(0)" ::: "memory");
  {
    int r32e = r32, hie = hi, lne = lane; asm volatile("" : "+v"(r32e), "+v"(hie), "+v"(lne));
    char* ot = lds + SHM_ATTN + wid * 4608;
    const int erow = lne >> 1, esub = (lne & 1) * 32;
#pragma unroll
    for (int h = 0; h < 2 * NV; ++h) {
#pragma unroll
      for (int r = 0; r < 16; ++r) { const int orow = crow(r, hie); const float rl = __builtin_amdgcn_rcpf(li_l[orow]);
#pragma unroll
        for (int dd = 0; dd < 2; ++dd) *(bf16_t*)(ot + orow * 144 + (dd * 32 + r32e) * 2) = f2bf(o[2 * h + dd][r] * rl); }
      asm volatile("s_waitcnt lgkmcnt(0)" ::: "memory");
      bf16_t* Op = U.O + (long)(wid * QBLK + erow) * U.ldo + h * 64 + esub;
      if (U.G) {
        const bf16_t* Gp = U.G + (long)(wid * QBLK + erow) * U.ldg + h * 64 + esub;
        u32x4 gv[4];
#pragma unroll
        for (int c = 0; c < 4; ++c) gv[c] = *reinterpret_cast<const u32x4*>(Gp + c * 8);
#pragma unroll
        for (int c = 0; c < 4; ++c) { const u32x4 ov = *reinterpret_cast<const u32x4*>(ot + erow * 144 + esub * 2 + c * 16); u32x4 w;
#pragma unroll
          for (int e = 0; e < 4; ++e) { const float g0 = silu_f(__uint_as_float(gv[c][e] << 16)), g1 = silu_f(__uint_as_float(gv[c][e] & 0xffff0000u));
            w[e] = cvt_pk_rn(__uint_as_float(ov[e] << 16) * g0, __uint_as_float(ov[e] & 0xffff0000u) * g1); }
          *reinterpret_cast<u32x4*>(Op + c * 8) = w; }
      } else {
#pragma unroll
        for (int c = 0; c < 4; ++c) *reinterpret_cast<u32x4*>(Op + c * 8) = *reinterpret_cast<const u32x4*>(ot + erow * 144 + esub * 2 + c * 16);
      }
      asm volatile("s_waitcnt lgkmcnt(0)" ::: "memory");
    }
  }
#undef DSYNC
#undef BSYNC
#undef DMA4_K
#undef DMA4_V
#undef RSRC
#undef DMA_K
#undef DMA_V
}
#undef KSWZ
#undef PIN
#undef MFMA32
#undef SBAR
}

constexpr int NTHR = 512, NWAVE = 8;

__device__ __forceinline__ bf16_t* wsb(const Params& p, size_t off) { return (bf16_t*)(p.ws + off); }
__device__ __forceinline__ float* wsf(const Params& p, size_t off) { return (float*)(p.ws + off); }
__device__ __forceinline__ const float* x_row(const Params& p, int l, int row) {
    if (l == 0) return row < M_CTX ? inp(IN_X_PROMPT) + (size_t)row * DM : inp(IN_X_SAMPLE) + (size_t)(row - M_CTX) * DM;
    return p.out + OUT_Y + (size_t)row * DM;
}

__device__ __forceinline__ void phase_mod(const Params& p, unsigned char* lds, int wv) {
    float* sl = (float*)lds;
    float* red = (float*)(lds + 9 * 2048 * 4);
    const int tid = opaque_tid(wv), wid = tid >> 6, lane = tid & 63;
    float* mod = wsf(p, WS_MOD);
    for (int u = blockIdx.x; u < 2 * 192; u += gridDim.x) {
        const int l = u / 192, j0 = (u % 192) * 64;
        const float* W = inp(IN_W_MOD) + (size_t)l * DM * MODW + j0 + lane;
        float acc[9];
#pragma unroll
        for (int ci = 0; ci < 9; ++ci) acc[ci] = 0.f;
        for (int kh = 0; kh < 2; ++kh) {
            __syncthreads();
            for (int i = tid; i < 9 * 2048; i += NTHR) { const int ci = i >> 11, k = kh * 2048 + (i & 2047);
                const float cv = (ci == 0) ? inp(IN_C_CTX)[k] : inp(IN_C)[(size_t)(ci - 1) * DM + k]; sl[i] = silu_f(cv); }
            __syncthreads();
            const int kb = wid * 256;
#pragma unroll 32
            for (int kk = 0; kk < 256; ++kk) {
                const float w = W[(size_t)(kh * 2048 + kb + kk) * MODW];
#pragma unroll
                for (int ci = 0; ci < 9; ++ci) acc[ci] += sl[ci * 2048 + kb + kk] * w;
            }
        }
#pragma unroll
        for (int ci = 0; ci < 9; ++ci) red[(wid * 9 + ci) * 64 + lane] = acc[ci];
        __syncthreads();
        for (int i = tid; i < 9 * 64; i += NTHR) { const int ci = i >> 6, col = i & 63; float s = 0.f;
#pragma unroll
            for (int w = 0; w < 8; ++w) s += red[(w * 9 + ci) * 64 + col];
            mod[((size_t)l * 9 + ci) * MODW + j0 + col] = s + inp(IN_B_MOD)[(size_t)l * MODW + j0 + col]; }
        __syncthreads();
    }
}

__device__ __forceinline__ int win_orig_col(int np) { return np < 4096 ? np : (np < 13312 ? np + 32 : (np < 13344 ? np - 13312 + 4096 : -1)); }
constexpr int CVT_NT_IN = (NPAD / 64) * 64, CVT_NT_OUT = 64 * 64;
__device__ __forceinline__ void cvt_weight_tile(const Params& p, int task, int wl_in, int wl_out, unsigned char* wt, int lane) {
    const float* src; bf16_t* dst; int ldsrc, nt, kt; bool isin;
    if (task < CVT_NT_IN) { nt = task % (NPAD / 64); kt = task / (NPAD / 64); src = inp(IN_W_IN) + (size_t)wl_in * DM * IN_COLS; ldsrc = IN_COLS; dst = wsb(p, WS_WINT) + (size_t)wl_in * NPAD * DM; isin = true; }
    else { const int r = task - CVT_NT_IN; nt = r & 63; kt = r >> 6; src = inp(IN_W_OUT) + (size_t)wl_out * DM * DM; ldsrc = DM; dst = wsb(p, WS_WOUTT) + (size_t)wl_out * DM * DM; isin = false; }
    const int n = nt * 64 + lane, k0 = kt * 64, oc = isin ? win_orig_col(n) : n;
    float v[64];
    const float* sp = src + (size_t)k0 * ldsrc + (oc >= 0 ? oc : 0);
#pragma unroll
    for (int k = 0; k < 64; ++k) v[k] = sp[(size_t)k * ldsrc];
    if (oc < 0) {
#pragma unroll
        for (int k = 0; k < 64; ++k) v[k] = 0.f; }
#pragma unroll
    for (int hf = 0; hf < 2; ++hf) {
        if ((lane >> 5) == hf) {
#pragma unroll
            for (int k8 = 0; k8 < 8; ++k8) *(uint4*)(wt + (lane & 31) * 144 + k8 * 16) = make_uint4(cvt_pk_rn(v[k8 * 8], v[k8 * 8 + 1]), cvt_pk_rn(v[k8 * 8 + 2], v[k8 * 8 + 3]), cvt_pk_rn(v[k8 * 8 + 4], v[k8 * 8 + 5]), cvt_pk_rn(v[k8 * 8 + 6], v[k8 * 8 + 7])); }
        asm volatile("s_waitcnt lgkmcnt(0)" ::: "memory");
#pragma unroll
        for (int it = 0; it < 4; ++it) { const int rr = it * 8 + (lane >> 3), ch = lane & 7;
            *(uint4*)(dst + (size_t)(nt * 64 + hf * 32 + rr) * DM + k0 + ch * 8) = *(const uint4*)(wt + rr * 144 + ch * 16); }
        asm volatile("s_waitcnt lgkmcnt(0)" ::: "memory");
    }
}
__device__ __forceinline__ void phase_cvt(const Params& p, unsigned char* lds, int wv) {
    const int tid = opaque_tid(wv), wid = tid >> 6, lane = tid & 63;
    { const int ub_ = (int)((long)blockIdx.x * (2 * CVT_NT_IN) / (long)gridDim.x), ue_ = (int)((long)(blockIdx.x + 1) * (2 * CVT_NT_IN) / (long)gridDim.x);
      for (int u = ub_ + wid; u < ue_; u += NWAVE) cvt_weight_tile(p, u % CVT_NT_IN, u / CVT_NT_IN, 0, lds + wid * 4608, lane); }
    {
        const size_t n_g = (size_t)8 * 2 * 256 * 512, n_d = (size_t)8 * 2 * 256 * 1024;
        const size_t tot4 = (2 * n_g + 2 * n_d) / 4;
        for (size_t i = (size_t)blockIdx.x * NTHR + tid; i < tot4; i += (size_t)gridDim.x * NTHR) {
            size_t e = i * 4; const float* s; bf16_t* d;
            if (e < n_g) { s = inp(IN_CACHE_GQA_K) + e; d = wsb(p, WS_CKG) + e; }
            else if (e < 2 * n_g) { e -= n_g; s = inp(IN_CACHE_GQA_V) + e; d = wsb(p, WS_CVG) + e; }
            else if (e < 2 * n_g + n_d) { e -= 2 * n_g; s = inp(IN_CACHE_DIFF_K) + e; d = wsb(p, WS_CKD) + e; }
            else { e -= 2 * n_g + n_d; s = inp(IN_CACHE_DIFF_V) + e; d = wsb(p, WS_CVD) + e; }
            const float4 v = *(const float4*)s; uint2 w; w.x = pk2bf(v.x, v.y); w.y = pk2bf(v.z, v.w); *(uint2*)d = w;
        }
    }
    { const int gw = blockIdx.x * NWAVE + wid;
      if (gw < 48) { const int l16 = lane & 15, sub = lane >> 4; const bool isg = gw < 16; const int bl = isg ? gw : (gw - 16) >> 1, grp = isg ? 0 : (gw - 16) & 1;
          const float* base = (isg ? inp(IN_CACHE_GQA_K) + (size_t)bl * 256 * 512 : inp(IN_CACHE_DIFF_K) + (size_t)bl * 256 * 1024 + grp * 512) + sub * 128 + l16 * 8;
          const int ld = isg ? 512 : 1024; float km = 0.f;
#pragma unroll 4
          for (int t = 0; t < 256; ++t) { const float4 a = *(const float4*)(base + (size_t)t * ld), c = *(const float4*)(base + (size_t)t * ld + 4);
              float s2 = a.x * a.x + a.y * a.y + a.z * a.z + a.w * a.w + c.x * c.x + c.y * c.y + c.z * c.z + c.w * c.w;
              s2 += __shfl_xor(s2, 1); s2 += __shfl_xor(s2, 2); s2 += __shfl_xor(s2, 4); s2 += __shfl_xor(s2, 8); km = fmaxf(km, s2); }
          if (l16 == 0) { const int b = bl >> 1, ll = bl & 1; float* ck = wsf(p, WS_CKM);
              if (isg) ck[(ll * 8 + b) * 4 + sub] = sqrtf(km); else ck[64 + (ll * 8 + b) * 8 + grp * 4 + sub] = sqrtf(km); } } }
    if (blockIdx.x == 0) {
        float* rope = wsf(p, WS_ROPE);
        for (int i = tid; i < 64 * 32; i += NTHR) { const int pos = i >> 5, fi = i & 31;
            const float inv = exp2f(-(float)(2 * fi) * (13.287712379549449f / 64.0f)); const float ang = (float)pos * inv;
            rope[i] = __cosf(ang); rope[2048 + i] = __sinf(ang); }
    }
}

__device__ __forceinline__ void phase_prenorm(const Params& p, int l, int wv) {
    const int tid = opaque_tid(wv), wid = tid >> 6, lane = tid & 63;
    const float* modl = wsf(p, WS_MOD) + (size_t)l * 9 * MODW; const float* pw = inp(IN_PRE_W) + (size_t)l * DM;
    bf16_t* H = wsb(p, WS_H);
    for (int row = blockIdx.x * NWAVE + wid; row < M_ALL; row += gridDim.x * NWAVE) {
        const float* x = x_row(p, l, row); const int ci = cond_of_row(row);
        float4 v[16]; float ss = 0.f;
#pragma unroll
        for (int i = 0; i < 16; ++i) { v[i] = *(const float4*)(x + (i * 64 + lane) * 4); ss += v[i].x * v[i].x + v[i].y * v[i].y + v[i].z * v[i].z + v[i].w * v[i].w; }
        ss = wave_sum(ss); const float rstd = rsqrtf(ss * (1.0f / DM) + NORM_EPS);
        const float* sh = modl + (size_t)ci * MODW; const float* sc = sh + DM;
#pragma unroll
        for (int i = 0; i < 16; ++i) { const int col = (i * 64 + lane) * 4;
            const float4 w = *(const float4*)(pw + col), s1 = *(const float4*)(sc + col), s0 = *(const float4*)(sh + col);
            uint2 o; o.x = pk2bf(v[i].x * rstd * w.x * (1.f + s1.x) + s0.x, v[i].y * rstd * w.y * (1.f + s1.y) + s0.y);
            o.y = pk2bf(v[i].z * rstd * w.z * (1.f + s1.z) + s0.z, v[i].w * rstd * w.w * (1.f + s1.w) + s0.w);
            *(uint2*)(H + (size_t)row * DM + col) = o; }
    }
}

__device__ __forceinline__ void phase_gemm1(const Params& p, int l, unsigned char* lds, int wv) {
    pg8::Gemm g; g.A = wsb(p, WS_H); g.Bt = wsb(p, WS_WINT) + (size_t)l * NPAD * DM; g.M = M_ALL; g.N = NPAD; g.K = DM;
    pg8::StaticOrder S; S.init(g.M, g.N, (int)gridDim.x, (int)blockIdx.x, 1);
    pg8::EpiZ E; E.ZA = wsb(p, WS_ZA); E.ZB = wsb(p, WS_ZB); E.ZC = wsb(p, WS_ZC); E.AB = wsf(p, WS_AB);
    pg8::gemm_phase<pg8::EpiZ, pg8::StaticOrder>((PG8_LAS unsigned char*)lds, g, S, E, wv);
}

__device__ __forceinline__ void phase_attnprep(const Params& p, int l, unsigned char* lds, int wv) {
    const int tid = opaque_tid(wv), wid = tid >> 6, lane = tid & 63, l16 = lane & 15, sub = lane >> 4, d0 = 8 * l16;
    unsigned* kt = (unsigned*)lds;
    for (int i = tid; i < KP_STRIDE; i += NTHR) kt[i] = 0u;
    __syncthreads();
    const float* rope = wsf(p, WS_ROPE);
    float qw[8], kw[8];
    { const float* qp = inp(IN_Q_NORM_W) + (size_t)l * 128 + d0; const float* kp = inp(IN_K_NORM_W) + (size_t)l * 128 + d0;
#pragma unroll
      for (int e = 0; e < 8; ++e) { qw[e] = qp[e]; kw[e] = kp[e]; } }
    bf16_t* ZB = wsb(p, WS_ZB); bf16_t* ZC = wsb(p, WS_ZC);
    const bool lo = (l16 & 4) == 0; const int jr = 8 * (l16 & 3);
    for (int row = blockIdx.x * NWAVE + wid; row < M_ALL; row += gridDim.x * NWAVE) {
        const bool ctx = row < M_CTX;
        bf16_t* zb = ZB + (size_t)row * ZB_W + sub * 128 + d0; bf16_t* zc = ZC + (size_t)row * ZC_W + sub * 128 + d0;
        uint4 v[12];
#pragma unroll
        for (int g = 0; g < 12; ++g) {
            const bool act = ctx ? (g == 4 || g == 5 || g >= 8) : (g == 4 || g == 8 || g == 9);
            bf16_t* ptr = g < 4 ? zb + g * 512 : (g == 4 ? zb + 2048 : (g == 5 ? zb + 2560 : zc + (g - 6) * 512));
            v[g] = act ? *(const uint4*)ptr : make_uint4(0u, 0u, 0u, 0u);
        }
        float cs[8], sn[8];
        if (!ctx) { const int tt = (row - M_CTX) & 4095; const int pos = (l16 & 8) ? (tt & 63) : (tt >> 6);
            const float4 c0 = *(const float4*)(rope + pos * 32 + jr), c1 = *(const float4*)(rope + pos * 32 + jr + 4), s0 = *(const float4*)(rope + 2048 + pos * 32 + jr), s1 = *(const float4*)(rope + 2048 + pos * 32 + jr + 4);
            cs[0] = c0.x; cs[1] = c0.y; cs[2] = c0.z; cs[3] = c0.w; cs[4] = c1.x; cs[5] = c1.y; cs[6] = c1.z; cs[7] = c1.w;
            sn[0] = s0.x; sn[1] = s0.y; sn[2] = s0.z; sn[3] = s0.w; sn[4] = s1.x; sn[5] = s1.y; sn[6] = s1.z; sn[7] = s1.w; }
        else {
#pragma unroll
            for (int e = 0; e < 8; ++e) { cs[e] = 1.f; sn[e] = 0.f; } }
        const int b = row >> 8, tt = row & 255; const size_t tb = ((size_t)(b * 2 + l) * 256 + tt);
#pragma unroll
        for (int g = 0; g < 12; ++g) {
            const bool act = ctx ? (g == 4 || g == 5 || g >= 8) : (g == 4 || g == 8 || g == 9);
            if (!act) continue;
            bf16_t* ptr = g < 4 ? zb + g * 512 : (g == 4 ? zb + 2048 : (g == 5 ? zb + 2560 : zc + (g - 6) * 512));
            float x[8]; const unsigned w[4] = {v[g].x, v[g].y, v[g].z, v[g].w};
#pragma unroll
            for (int e = 0; e < 4; ++e) { x[2 * e] = __uint_as_float(w[e] << 16); x[2 * e + 1] = __uint_as_float(w[e] & 0xffff0000u); }
            if (g <= 4) { float ss = 0.f;
#pragma unroll
                for (int e = 0; e < 8; ++e) ss += x[e] * x[e];
                ss += __shfl_xor(ss, 1); ss += __shfl_xor(ss, 2); ss += __shfl_xor(ss, 4); ss += __shfl_xor(ss, 8);
                const float r = rsqrtf(ss * (1.0f / 128.0f) + NORM_EPS);
#pragma unroll
                for (int e = 0; e < 8; ++e) x[e] *= r * (g < 4 ? qw[e] : kw[e]); }
            if (g == 4 || g == 8 || g == 9) {
                float s2 = 0.f;
#pragma unroll
                for (int e = 0; e < 8; ++e) s2 += x[e] * x[e];
                s2 += __shfl_xor(s2, 1); s2 += __shfl_xor(s2, 2); s2 += __shfl_xor(s2, 4); s2 += __shfl_xor(s2, 8);
                if (l16 == 0) { const int seq = ctx ? (row >> 8) : 16 + ((row - M_CTX) >> 12), slot = g == 4 ? sub : 4 + (g - 8) * 4 + sub;
                    atomicMax(&kt[seq * 12 + slot], __float_as_uint(sqrtf(s2))); } }
            if (ctx) {
                if (g >= 4) { float* o = g == 4 ? p.out + OUT_GK + tb * 512 : (g == 5 ? p.out + OUT_GV + tb * 512 : (g < 10 ? p.out + OUT_DK + tb * 1024 + (g - 8) * 512 : p.out + OUT_DV + tb * 1024 + (g - 10) * 512));
                    o += sub * 128 + d0;
                    *(float4*)o = make_float4(x[0], x[1], x[2], x[3]); *(float4*)(o + 4) = make_float4(x[4], x[5], x[6], x[7]); }
                if (g <= 4) { uint4 ov; ov.x = cvt_pk_rn(x[0], x[1]); ov.y = cvt_pk_rn(x[2], x[3]); ov.z = cvt_pk_rn(x[4], x[5]); ov.w = cvt_pk_rn(x[6], x[7]); *(uint4*)ptr = ov; }
            } else {
                float y[8];
#pragma unroll
                for (int e = 0; e < 8; ++e) { const float pr = __shfl_xor(x[e], 4); y[e] = lo ? x[e] * cs[e] - pr * sn[e] : x[e] * cs[e] + pr * sn[e]; }
                uint4 ov; ov.x = cvt_pk_rn(y[0], y[1]); ov.y = cvt_pk_rn(y[2], y[3]); ov.z = cvt_pk_rn(y[4], y[5]); ov.w = cvt_pk_rn(y[6], y[7]); *(uint4*)ptr = ov;
            }
        }
    }
    __syncthreads();
    { float* kp = wsf(p, WS_KP) + (size_t)blockIdx.x * KP_STRIDE; for (int i = tid; i < KP_STRIDE; i += NTHR) kp[i] = __uint_as_float(kt[i]); }
}

__device__ __forceinline__ void phase_attn(const Params& p, int l, unsigned char* lds, int wv) {
    bf16_t* ZB = wsb(p, WS_ZB); bf16_t* ZC = wsb(p, WS_ZC); bf16_t* MIX = wsb(p, WS_H); bf16_t* DT = wsb(p, WS_DTMP);
    const float* qnw = inp(IN_Q_NORM_W) + (size_t)l * 128; const float* ropet = wsf(p, WS_ROPE);
    const bf16_t* CKG = wsb(p, WS_CKG); const bf16_t* CVG = wsb(p, WS_CVG); const bf16_t* CKD = wsb(p, WS_CKD); const bf16_t* CVD = wsb(p, WS_CVD);
    const float* KP = wsf(p, WS_KP); const float* CKM = wsf(p, WS_CKM);
    const int G = gridDim.x, cswz = (G & 7) == 0 ? (int)(blockIdx.x & 7) * (G >> 3) + (int)(blockIdx.x >> 3) : (int)blockIdx.x;
    const int bg_ntask = CVT_NT_OUT, bg_calls = 2880 / G, bg_nslot = bg_calls * G * 4; int bg_call = 0;
    for (int w = cswz; w < 2880; w += G) {
        const bool dgroup = (w >= 2048 && w < 2560) || w >= 2816;
        const int nsub = dgroup ? 2 : 1;
        size_t r0c = 0; int hc = 0;
        for (int sub = 0; sub < nsub; ++sub) {
            att::Unit U;
            if (w < 2048) {
                const int b = w >> 8, rem = w & 255, kvh = rem >> 6, qb = (rem & 63) >> 2, g = rem & 3, hq = kvh * 4 + g;
                const size_t s0 = (size_t)M_CTX + (size_t)b * 4096, r0 = s0 + (size_t)qb * 256;
                U.Q = ZB + r0 * ZB_W + hq * 128; U.ldq = ZB_W; U.qw = qnw; U.rope = ropet; U.t0 = qb * 256;
                U.K1 = ZB + s0 * ZB_W + 2048 + kvh * 128; U.V1 = U.K1 + 512; U.ld1 = ZB_W; U.n1 = 4096;
                const size_t cb = (size_t)(b * 2 + l) * 256 * 512 + kvh * 128;
                U.K2 = CKG + cb; U.V2 = CVG + cb; U.ld2 = 512; U.n2 = 256;
                U.O = MIX + r0 * DM + 1024 + hq * 128; U.ldo = DM; U.G = ZB + r0 * ZB_W + 3072 + hq * 128; U.ldg = ZB_W;
                U.kp = KP + (16 + b) * 12 + kvh; U.kcm = CKM[(l * 8 + b) * 4 + kvh];
            } else if (w < 2560) {
                const int v = w - 2048, b = v >> 6, h = (v >> 4) & 3, qb = v & 15, i = sub;
                const size_t s0 = (size_t)M_CTX + (size_t)b * 4096, r0 = s0 + (size_t)qb * 256; r0c = r0; hc = h;
                U.Q = ZC + r0 * ZC_W + h * 256 + i * 128; U.ldq = ZC_W; U.qw = nullptr; U.rope = ropet; U.t0 = qb * 256;
                U.K1 = ZC + s0 * ZC_W + 1024 + h * 256 + i * 128; U.V1 = ZC + s0 * ZC_W + 2048 + h * 256; U.ld1 = ZC_W; U.n1 = 4096;
                const size_t cb = (size_t)(b * 2 + l) * 256 * 1024 + h * 256;
                U.K2 = CKD + cb + i * 128; U.V2 = CVD + cb; U.ld2 = 1024; U.n2 = 256;
                U.O = DT + (size_t)i * M_ALL * 1024 + r0 * 1024 + h * 256; U.ldo = 1024; U.G = nullptr; U.ldg = 0;
                U.kp = KP + (16 + b) * 12 + 4 + h * 2 + i; U.kcm = CKM[64 + (l * 8 + b) * 8 + h * 2 + i];
            } else if (w < 2816) {
                const int v = w - 2560, b = v >> 4, hq = v & 15; const size_t r0 = (size_t)b * 256;
                U.Q = ZB + r0 * ZB_W + hq * 128; U.ldq = ZB_W; U.qw = qnw; U.rope = nullptr; U.t0 = 0;
                U.K1 = ZB + r0 * ZB_W + 2048 + (hq >> 2) * 128; U.V1 = U.K1 + 512; U.ld1 = ZB_W; U.n1 = 256;
                U.K2 = U.K1; U.V2 = U.V1; U.ld2 = ZB_W; U.n2 = 0;
                U.O = MIX + r0 * DM + 1024 + hq * 128; U.ldo = DM; U.G = ZB + r0 * ZB_W + 3072 + hq * 128; U.ldg = ZB_W;
                U.kp = KP + b * 12 + (hq >> 2); U.kcm = 0.f;
            } else {
                const int v = w - 2816, b = v >> 2, h = v & 3, i = sub; const size_t r0 = (size_t)b * 256; r0c = r0; hc = h;
                U.Q = ZC + r0 * ZC_W + h * 256 + i * 128; U.ldq = ZC_W; U.qw = nullptr; U.rope = nullptr; U.t0 = 0;
                U.K1 = ZC + r0 * ZC_W + 1024 + h * 256 + i * 128; U.V1 = ZC + r0 * ZC_W + 2048 + h * 256; U.ld1 = ZC_W; U.n1 = 256;
                U.K2 = U.K1; U.V2 = U.V1; U.ld2 = ZC_W; U.n2 = 0;
                U.O = DT + (size_t)i * M_ALL * 1024 + r0 * 1024 + h * 256; U.ldo = 1024; U.G = nullptr; U.ldg = 0;
                U.kp = KP + b * 12 + 4 + h * 2 + i; U.kcm = 0.f;
            }
            if (dgroup) att::attn_unit<2>(U, (char*)lds, wv); else att::attn_unit<1>(U, (char*)lds, wv);
            if (bg_call < bg_calls) {
                if (wv < 4) { const int lane_bg = opaque_tid(wv) & 63;
                    for (int task = (bg_call * G + (int)blockIdx.x) * 4 + wv; task < bg_ntask; task += bg_nslot)
                        cvt_weight_tile(p, task + CVT_NT_IN, 0, l, lds + att::SHM_ATTN + wv * 4608, lane_bg); }
                ++bg_call; }
        }
        if (dgroup) {
            asm volatile("s_waitcnt vmcnt(0)" ::: "memory");
            const int tid = opaque_tid(wv), wid = tid >> 6, lane = tid & 63, l16 = lane & 15, rsub = lane >> 4;
            int ll = l; asm volatile("" : "+s"(ll));
            const float lam_init = ll == 0 ? 0.2f : (0.8f - 0.6f * 0.74081822068171788f);
            const float* lp = inp(IN_DIFF_LAMBDA) + (size_t)ll * 4 * 128;
            float s1 = lp[lane] * lp[128 + lane] + lp[64 + lane] * lp[128 + 64 + lane], s2 = lp[256 + lane] * lp[384 + lane] + lp[256 + 64 + lane] * lp[384 + 64 + lane];
#pragma unroll
            for (int o2 = 32; o2 >= 1; o2 >>= 1) { s1 += shfl_xor_at(s1, o2, lane); s2 += shfl_xor_at(s2, o2, lane); }
            const float lam = expf(s1) - expf(s2) + lam_init;
            float nw[16];
            { const float* np = inp(IN_DIFF_NORM_W) + (size_t)ll * 256 + l16 * 16;
#pragma unroll
              for (int e = 0; e < 16; ++e) nw[e] = np[e]; }
            const int c = hc * 256 + l16 * 16;
            for (int it = 0; it < 8; ++it) { const size_t row = r0c + wid * 32 + it * 4 + rsub;
                const bf16_t* a0p = DT + row * 1024 + c; const bf16_t* a1p = a0p + (size_t)M_ALL * 1024; const bf16_t* gp = ZC + row * ZC_W + 3072 + c;
                const uint4 a0a = *(const uint4*)a0p, a0b = *(const uint4*)(a0p + 8), a1a = *(const uint4*)a1p, a1b = *(const uint4*)(a1p + 8), ga = *(const uint4*)gp, gb = *(const uint4*)(gp + 8);
                const unsigned w0[8] = {a0a.x, a0a.y, a0a.z, a0a.w, a0b.x, a0b.y, a0b.z, a0b.w}, w1[8] = {a1a.x, a1a.y, a1a.z, a1a.w, a1b.x, a1b.y, a1b.z, a1b.w}, wg[8] = {ga.x, ga.y, ga.z, ga.w, gb.x, gb.y, gb.z, gb.w};
                float o[16]; float ss = 0.f;
#pragma unroll
                for (int e = 0; e < 8; ++e) { o[2 * e] = __uint_as_float(w0[e] << 16) - lam * __uint_as_float(w1[e] << 16); o[2 * e + 1] = __uint_as_float(w0[e] & 0xffff0000u) - lam * __uint_as_float(w1[e] & 0xffff0000u);
                    ss += o[2 * e] * o[2 * e] + o[2 * e + 1] * o[2 * e + 1]; }
                ss += shfl_xor_at(ss, 1, lane); ss += shfl_xor_at(ss, 2, lane); ss += shfl_xor_at(ss, 4, lane); ss += shfl_xor_at(ss, 8, lane);
                const float r = rsqrtf(ss * (1.0f / 256.0f) + NORM_EPS) * (1.0f - lam_init);
                unsigned ov[8];
#pragma unroll
                for (int e = 0; e < 8; ++e) ov[e] = cvt_pk_rn(o[2 * e] * r * nw[2 * e] * silu_f(__uint_as_float(wg[e] << 16)), o[2 * e + 1] * r * nw[2 * e + 1] * silu_f(__uint_as_float(wg[e] & 0xffff0000u)));
                bf16_t* op = MIX + row * DM + 3072 + c;
                *(uint4*)op = make_uint4(ov[0], ov[1], ov[2], ov[3]); *(uint4*)(op + 8) = make_uint4(ov[4], ov[5], ov[6], ov[7]); }
        }
    }
}

__device__ __forceinline__ void phase_dncomb(const Params& p, int l, int wv) {
    const int tid = opaque_tid(wv), wid = tid >> 6, lane = tid & 63, l16 = lane & 15, sub = lane >> 4;
    const bf16_t* DNO = wsb(p, WS_DNO); const bf16_t* ZA = wsb(p, WS_ZA); bf16_t* MIX = wsb(p, WS_H);
    float nw[8];
    { const float* np = inp(IN_DN_NORM_W) + (size_t)l * 128 + l16 * 8;
#pragma unroll
      for (int e = 0; e < 8; ++e) nw[e] = np[e]; }
    for (int row = blockIdx.x * NWAVE + wid; row < M_ALL; row += gridDim.x * NWAVE) {
        uint4 a[2], b[2]; uint4 g[2];
#pragma unroll
        for (int gi = 0; gi < 2; ++gi) { const int c = (gi * 4 + sub) * 128 + l16 * 8;
            a[gi] = *(const uint4*)(DNO + (size_t)row * 1024 + c); b[gi] = *(const uint4*)(DNO + ((size_t)M_ALL + row) * 1024 + c);
            g[gi] = *(const uint4*)(ZA + (size_t)row * ZA_W + 3072 + c); }
#pragma unroll
        for (int gi = 0; gi < 2; ++gi) { const int c = (gi * 4 + sub) * 128 + l16 * 8;
            const unsigned wa[4] = {a[gi].x, a[gi].y, a[gi].z, a[gi].w}, wb[4] = {b[gi].x, b[gi].y, b[gi].z, b[gi].w}; float x[8];
#pragma unroll
            for (int e = 0; e < 4; ++e) { x[2 * e] = __uint_as_float(wa[e] << 16) + __uint_as_float(wb[e] << 16); x[2 * e + 1] = __uint_as_float(wa[e] & 0xffff0000u) + __uint_as_float(wb[e] & 0xffff0000u); }
            float ss = 0.f;
#pragma unroll
            for (int e = 0; e < 8; ++e) ss += x[e] * x[e];
            ss += __shfl_xor(ss, 1); ss += __shfl_xor(ss, 2); ss += __shfl_xor(ss, 4); ss += __shfl_xor(ss, 8);
            const float r = rsqrtf(ss * (1.0f / 128.0f) + NORM_EPS);
            const unsigned wg[4] = {g[gi].x, g[gi].y, g[gi].z, g[gi].w}; unsigned ov[4];
#pragma unroll
            for (int e = 0; e < 4; ++e) ov[e] = cvt_pk_rn(x[2 * e] * r * nw[2 * e] * silu_f(__uint_as_float(wg[e] << 16)), x[2 * e + 1] * r * nw[2 * e + 1] * silu_f(__uint_as_float(wg[e] & 0xffff0000u)));
            *(uint4*)(MIX + (size_t)row * DM + c) = make_uint4(ov[0], ov[1], ov[2], ov[3]); }
    }
}

__device__ __forceinline__ void phase_gemm2(const Params& p, int l, unsigned char* lds, int wv) {
    pg8::Gemm g; g.A = wsb(p, WS_H); g.Bt = wsb(p, WS_WOUTT) + (size_t)l * DM * DM; g.M = M_ALL; g.N = DM; g.K = DM;
    pg8::StaticOrder S; S.init(g.M, g.N, (int)gridDim.x, (int)blockIdx.x);
    pg8::EpiB16 E; E.O = wsb(p, WS_O2); E.ld = DM;
    pg8::gemm_phase<pg8::EpiB16, pg8::StaticOrder>((PG8_LAS unsigned char*)lds, g, S, E, wv);
}

template <bool NEXT>
__device__ __forceinline__ void phase_postnorm(const Params& p, int l, int wv) {
    const int tid = opaque_tid(wv), wid = tid >> 6, lane = tid & 63;
    const float* modl = wsf(p, WS_MOD) + (size_t)l * 9 * MODW; const float* pw = inp(IN_POST_W) + (size_t)l * DM;
    const float* modn = modl + 9 * MODW; const float* pwn = inp(IN_PRE_W) + (size_t)(l + 1) * DM;
    const bf16_t* O2 = wsb(p, WS_O2); bf16_t* H = wsb(p, WS_H);
    for (int row = blockIdx.x * NWAVE + wid; row < M_ALL; row += gridDim.x * NWAVE) {
        const float* x = x_row(p, 0, row); const bf16_t* o2 = O2 + (size_t)row * DM; const int ci = cond_of_row(row);
        float* y = p.out + OUT_Y + (size_t)row * DM; bf16_t* y0 = (bf16_t*)y;
        uint4 v[8]; float4 xa[8], xb[8]; float ss = 0.f;
#pragma unroll
        for (int i = 0; i < 8; ++i) { v[i] = *(const uint4*)(o2 + (i * 64 + lane) * 8);
            if constexpr (NEXT) { xa[i] = *(const float4*)(x + (i * 64 + lane) * 8); xb[i] = *(const float4*)(x + (i * 64 + lane) * 8 + 4); }
            else { const uint4 xv = *(const uint4*)(y0 + (i * 64 + lane) * 8);
                xa[i] = make_float4(__uint_as_float(xv.x << 16), __uint_as_float(xv.x & 0xffff0000u), __uint_as_float(xv.y << 16), __uint_as_float(xv.y & 0xffff0000u));
                xb[i] = make_float4(__uint_as_float(xv.z << 16), __uint_as_float(xv.z & 0xffff0000u), __uint_as_float(xv.w << 16), __uint_as_float(xv.w & 0xffff0000u)); } }
#pragma unroll
        for (int i = 0; i < 8; ++i) {
            const unsigned w4[4] = {v[i].x, v[i].y, v[i].z, v[i].w};
#pragma unroll
            for (int e = 0; e < 4; ++e) { const float a = __uint_as_float(w4[e] << 16), b = __uint_as_float(w4[e] & 0xffff0000u); ss += a * a + b * b; } }
        ss = wave_sum(ss); const float rstd = rsqrtf(ss * (1.0f / DM) + NORM_EPS);
        const float* gt = modl + (size_t)ci * MODW + 2 * DM;
        float yv[8][8]; float ssy = 0.f;
#pragma unroll
        for (int i = 0; i < 8; ++i) { const int col = (i * 64 + lane) * 8;
            const float4 w0 = *(const float4*)(pw + col), w1 = *(const float4*)(pw + col + 4), g0 = *(const float4*)(gt + col), g1 = *(const float4*)(gt + col + 4), x0 = xa[i], x1 = xb[i];
            const unsigned w4[4] = {v[i].x, v[i].y, v[i].z, v[i].w};
            const float ww[8] = {w0.x, w0.y, w0.z, w0.w, w1.x, w1.y, w1.z, w1.w}, gg[8] = {g0.x, g0.y, g0.z, g0.w, g1.x, g1.y, g1.z, g1.w}, xx[8] = {x0.x, x0.y, x0.z, x0.w, x1.x, x1.y, x1.z, x1.w};
#pragma unroll
            for (int e = 0; e < 4; ++e) { const float a = __uint_as_float(w4[e] << 16), b = __uint_as_float(w4[e] & 0xffff0000u);
                yv[i][2 * e] = xx[2 * e] + gg[2 * e] * a * rstd * ww[2 * e]; yv[i][2 * e + 1] = xx[2 * e + 1] + gg[2 * e + 1] * b * rstd * ww[2 * e + 1]; }
            if constexpr (NEXT) *(uint4*)(y0 + col) = make_uint4(cvt_pk_rn(yv[i][0], yv[i][1]), cvt_pk_rn(yv[i][2], yv[i][3]), cvt_pk_rn(yv[i][4], yv[i][5]), cvt_pk_rn(yv[i][6], yv[i][7]));
            else { *(float4*)(y + col) = make_float4(yv[i][0], yv[i][1], yv[i][2], yv[i][3]); *(float4*)(y + col + 4) = make_float4(yv[i][4], yv[i][5], yv[i][6], yv[i][7]); }
            if (NEXT) {
#pragma unroll
                for (int e = 0; e < 8; ++e) ssy += yv[i][e] * yv[i][e]; } }
        if (NEXT) {
            ssy = wave_sum(ssy); const float rsy = rsqrtf(ssy * (1.0f / DM) + NORM_EPS);
            const float* sh = modn + (size_t)ci * MODW; const float* sc = sh + DM;
#pragma unroll
            for (int i = 0; i < 8; ++i) { const int col = (i * 64 + lane) * 8;
                const float4 w0 = *(const float4*)(pwn + col), w1 = *(const float4*)(pwn + col + 4), a0 = *(const float4*)(sc + col), a1 = *(const float4*)(sc + col + 4), b0 = *(const float4*)(sh + col), b1 = *(const float4*)(sh + col + 4);
                const float ww[8] = {w0.x, w0.y, w0.z, w0.w, w1.x, w1.y, w1.z, w1.w}, aa[8] = {a0.x, a0.y, a0.z, a0.w, a1.x, a1.y, a1.z, a1.w}, bb[8] = {b0.x, b0.y, b0.z, b0.w, b1.x, b1.y, b1.z, b1.w};
                unsigned ov[4];
#pragma unroll
                for (int e = 0; e < 4; ++e) ov[e] = cvt_pk_rn(yv[i][2 * e] * rsy * ww[2 * e] * (1.f + aa[2 * e]) + bb[2 * e], yv[i][2 * e + 1] * rsy * ww[2 * e + 1] * (1.f + aa[2 * e + 1]) + bb[2 * e + 1]);
                *(uint4*)(H + (size_t)row * DM + col) = make_uint4(ov[0], ov[1], ov[2], ov[3]); }
        }
    }
}

namespace dn {
using bf16x8 = __attribute__((ext_vector_type(8))) short;
using s16x4 = __attribute__((ext_vector_type(4))) short;
using f32x4 = __attribute__((ext_vector_type(4))) float;
using u32x4 = __attribute__((ext_vector_type(4))) unsigned;
#define DN_LFENCE() asm volatile("s_waitcnt lgkmcnt(0)" ::: "memory")
__device__ __forceinline__ unsigned cvtpk(float lo, float hi) { return cvt_pk_rn(lo, hi); }
__device__ __forceinline__ bf16x8 mk8(uint2 a, uint2 b) { u32x4 w = {a.x, a.y, b.x, b.y}; return *reinterpret_cast<bf16x8*>(&w); }
__device__ __forceinline__ bf16x8 pack8(f32x4 a, f32x4 b) { u32x4 w = {cvtpk(a[0], a[1]), cvtpk(a[2], a[3]), cvtpk(b[0], b[1]), cvtpk(b[2], b[3])}; return *reinterpret_cast<bf16x8*>(&w); }
__device__ __forceinline__ bf16x8 tr_read2(unsigned a0, unsigned a1) {
    s16x4 lo, hi;
    asm volatile("ds_read_b64_tr_b16 %0, %2\n\tds_read_b64_tr_b16 %1, %3\n\ts_waitcnt lgkmcnt(0)" : "=&v"(lo), "=&v"(hi) : "v"(a0), "v"(a1) : "memory");
    return (bf16x8){lo[0], lo[1], lo[2], lo[3], hi[0], hi[1], hi[2], hi[3]};
}
}

__device__ __forceinline__ void phase_dnpre(const Params& p, int l, int wv) {
    const int tid = opaque_tid(wv), wid = tid >> 6, lane = tid & 63, g = lane >> 4, cg = (lane & 15) * 8;
    const bf16_t* ZA = wsb(p, WS_ZA); bf16_t* QKV = wsb(p, WS_QKVR);
    const float* cw = inp(IN_CONV_W) + (size_t)l * 3 * 3072;
    const int ntask = (M_ALL / 4) * 6;
    for (int t = blockIdx.x * NWAVE + wid; t < ntask; t += gridDim.x * NWAVE) {
        const int r4 = t / 6, hg = t % 6, row = r4 * 4 + g;
        int pos, T; if (row < M_CTX) { pos = row & 255; T = 256; } else { pos = (row - M_CTX) & 4095; T = 4096; }
        const bool vm = pos > 0, vp = pos < T - 1;
        uint4 xin[4][3];
#pragma unroll
        for (int hh = 0; hh < 4; ++hh) { const int cbase = (hg * 4 + hh) * 128 + cg; const bf16_t* xr = ZA + (size_t)row * ZA_W + cbase;
            xin[hh][0] = vm ? *(const uint4*)(xr - ZA_W) : make_uint4(0u, 0u, 0u, 0u); xin[hh][1] = *(const uint4*)xr; xin[hh][2] = vp ? *(const uint4*)(xr + ZA_W) : make_uint4(0u, 0u, 0u, 0u); }
#pragma unroll
        for (int hh = 0; hh < 4; ++hh) { const int cbase = (hg * 4 + hh) * 128 + cg;
            float y[8];
#pragma unroll
            for (int e = 0; e < 8; ++e) y[e] = 0.f;
#pragma unroll
            for (int tap = 0; tap < 3; ++tap) { const uint4 a = xin[hh][tap];
                const float4 w0 = *(const float4*)(cw + (size_t)tap * 3072 + cbase), w1 = *(const float4*)(cw + (size_t)tap * 3072 + cbase + 4);
                y[0] += __uint_as_float(a.x << 16) * w0.x; y[1] += __uint_as_float(a.x & 0xffff0000u) * w0.y; y[2] += __uint_as_float(a.y << 16) * w0.z; y[3] += __uint_as_float(a.y & 0xffff0000u) * w0.w;
                y[4] += __uint_as_float(a.z << 16) * w1.x; y[5] += __uint_as_float(a.z & 0xffff0000u) * w1.y; y[6] += __uint_as_float(a.w << 16) * w1.z; y[7] += __uint_as_float(a.w & 0xffff0000u) * w1.w; }
            float ss = 0.f;
#pragma unroll
            for (int e = 0; e < 8; ++e) { y[e] = silu_f(y[e]); ss += y[e] * y[e]; }
            float sc = 1.f;
            if (hg < 4) { ss += __shfl_xor(ss, 1); ss += __shfl_xor(ss, 2); ss += __shfl_xor(ss, 4); ss += __shfl_xor(ss, 8); sc = rsqrtf(ss + NORM_EPS); }
            uint4 o; o.x = dn::cvtpk(y[0] * sc, y[1] * sc); o.y = dn::cvtpk(y[2] * sc, y[3] * sc); o.z = dn::cvtpk(y[4] * sc, y[5] * sc); o.w = dn::cvtpk(y[6] * sc, y[7] * sc);
            *(uint4*)(QKV + (size_t)row * 3072 + cbase) = o; }
    }
}

constexpr int DNB_REGION = 17920;
__device__ __forceinline__ void phase_dnb(const Params& p, int l, unsigned char* lds, int wv) {
    using namespace dn;
    const int tid = opaque_tid(wv), wid = __builtin_amdgcn_readfirstlane(tid >> 6), lane0 = tid & 63;
#define DNB_RELANE() int lane = lane0; asm volatile("" : "+v"(lane)); const int fr = lane & 15, fq = lane >> 4; (void)fr; (void)fq
    unsigned char* R = lds + wid * DNB_REGION;
    float* Rf = (float*)R;
    float* gcs = (float*)(R + 17408); float* bts = gcs + 64;
    const unsigned rb = (unsigned)(uintptr_t)R;
    const bf16_t* QKV = wsb(p, WS_QKVR); const float* AB = wsf(p, WS_AB);
    unsigned char* DNP = p.ws + WS_DNP;
    const float* alog = inp(IN_A_LOG); const float* dtbp = inp(IN_DT_BIAS);
    const int ub_ = (int)((long)blockIdx.x * 9216 / (long)gridDim.x), ue_ = (int)((long)(blockIdx.x + 1) * 9216 / (long)gridDim.x);
    for (int u = ub_ + wid; u < ue_; u += NWAVE) {
        const int dir = u & 1, h = (u >> 1) & 7, row0 = (u >> 4) * 64;
        unsigned char* U = DNP + (size_t)u * DN_UNIT;
        const int hq = h * 128, hk = 1024 + h * 128, hv = 2048 + h * 128;
        bf16x8 Kf[4][4];
        { DNB_RELANE();
#pragma unroll
        for (int mt = 0; mt < 4; ++mt) { const int i = 16 * mt + fr; const bf16_t* kr = QKV + (size_t)(row0 + (dir ? 63 - i : i)) * 3072 + hk + 4 * fq;
#pragma unroll
            for (int kk = 0; kk < 4; ++kk) Kf[mt][kk] = mk8(*(const uint2*)(kr + 32 * kk), *(const uint2*)(kr + 32 * kk + 16)); } }
        { DNB_RELANE();
            const float aneg = -__expf(alog[(l * 2 + dir) * 8 + h]), dtb = dtbp[(l * 2 + dir) * 8 + h];
            const float* ab = AB + (size_t)(row0 + (dir ? 63 - lane : lane)) * 32;
            const float al = ab[dir * 8 + h] + dtb; const float ee = __expf(-fabsf(al)); const float sp = fmaxf(al, 0.f) + (ee < 1e-3f ? ee * (1.0f - ee * (0.5f - ee * 0.33333334f)) : __logf(1.0f + ee));
            float g = aneg * sp; const float beta = 1.0f / (1.0f + __expf(-ab[16 + dir * 8 + h]));
#pragma unroll
            for (int o = 1; o < 64; o <<= 1) { const float v = __shfl_up(g, o); if (lane >= o) g += v; }
            gcs[lane] = g; bts[lane] = beta; ((float*)(U + DNU_GC))[lane] = g;
        }
        DN_LFENCE();
        { DNB_RELANE();
#pragma unroll
        for (int mt = 0; mt < 4; ++mt) { const float4 gi = *(const float4*)(gcs + 16 * mt + 4 * fq), bi = *(const float4*)(bts + 16 * mt + 4 * fq);
#pragma unroll
            for (int nt = 0; nt < 4; ++nt) { float o4[4] = {0.f, 0.f, 0.f, 0.f};
                if (nt <= mt) { f32x4 acc = {0.f, 0.f, 0.f, 0.f};
#pragma unroll
                    for (int kk = 0; kk < 4; ++kk) acc = __builtin_amdgcn_mfma_f32_16x16x32_bf16(Kf[mt][kk], Kf[nt][kk], acc, 0, 0, 0);
                    const int j = 16 * nt + fr; const float gj = gcs[j]; const float giv[4] = {gi.x, gi.y, gi.z, gi.w}, biv[4] = {bi.x, bi.y, bi.z, bi.w};
#pragma unroll
                    for (int r = 0; r < 4; ++r) { const int i = 16 * mt + 4 * fq + r; const float e = __expf(fminf(giv[r] - gj, 0.f)); o4[r] = (i > j) ? biv[r] * acc[r] * e : 0.f; } }
#pragma unroll
                for (int r = 0; r < 4; ++r) Rf[(16 * mt + 4 * fq + r) * 68 + 16 * nt + fr] = o4[r]; } } }
        { DNB_RELANE();
#pragma unroll
        for (int mt = 0; mt < 4; ++mt) { const int i = 16 * mt + fr; const bf16_t* qr = QKV + (size_t)(row0 + (dir ? 63 - i : i)) * 3072 + hq + 4 * fq;
            bf16x8 Qf[4];
#pragma unroll
            for (int kk = 0; kk < 4; ++kk) { Qf[kk] = mk8(*(const uint2*)(qr + 32 * kk), *(const uint2*)(qr + 32 * kk + 16)); *(bf16x8*)(U + DNU_Q + ((mt * 4 + kk) * 64 + lane) * 16) = Qf[kk]; }
            const float gi = gcs[i];
#pragma unroll
            for (int k2 = 0; k2 < 2; ++k2) { f32x4 t2[2];
#pragma unroll
                for (int s2 = 0; s2 < 2; ++s2) { const int nt = 2 * k2 + s2; t2[s2] = (f32x4){0.f, 0.f, 0.f, 0.f};
                    if (nt <= mt) { f32x4 acc = {0.f, 0.f, 0.f, 0.f};
#pragma unroll
                        for (int kk = 0; kk < 4; ++kk) acc = __builtin_amdgcn_mfma_f32_16x16x32_bf16(Kf[nt][kk], Qf[kk], acc, 0, 0, 0);
                        const float4 gj = *(const float4*)(gcs + 16 * nt + 4 * fq); const float gjv[4] = {gj.x, gj.y, gj.z, gj.w};
#pragma unroll
                        for (int r = 0; r < 4; ++r) { const int j = 16 * nt + 4 * fq + r; const float e = __expf(fminf(gi - gjv[r], 0.f)); t2[s2][r] = (i >= j) ? ATT_SCALE * acc[r] * e : 0.f; } } }
                *(bf16x8*)(U + DNU_QK + ((mt * 2 + k2) * 64 + lane) * 16) = pack8(t2[0], t2[1]); } } }
        u32x4 tile[16];
        { DNB_RELANE();
#pragma unroll
        for (int it = 0; it < 16; ++it) { const int j = it * 4 + (lane >> 4); tile[it] = *(const u32x4*)(QKV + (size_t)(row0 + (dir ? 63 - j : j)) * 3072 + hk + (lane & 15) * 8); } }
        DN_LFENCE();
        { DNB_RELANE();
        for (int b4 = 0; b4 < 16; ++b4) { const int i0 = 4 * b4;
            float acc[4];
#pragma unroll
            for (int r = 0; r < 4; ++r) acc[r] = -Rf[(i0 + r) * 68 + lane];
#pragma unroll 2
            for (int j = 0; j < i0; j += 4) {
                const float n0 = Rf[(j + 0) * 68 + lane], n1 = Rf[(j + 1) * 68 + lane], n2 = Rf[(j + 2) * 68 + lane], n3 = Rf[(j + 3) * 68 + lane];
#pragma unroll
                for (int r = 0; r < 4; ++r) { const float4 a = *(const float4*)(Rf + (i0 + r) * 68 + j); acc[r] -= (a.x * n0 + a.y * n1) + (a.z * n2 + a.w * n3); } }
            const float4 d1 = *(const float4*)(Rf + (i0 + 1) * 68 + i0), d2 = *(const float4*)(Rf + (i0 + 2) * 68 + i0), d3 = *(const float4*)(Rf + (i0 + 3) * 68 + i0);
            const float x0 = (lane < i0) ? acc[0] : 0.f;
            const float x1 = (lane < i0 + 1) ? acc[1] - d1.x * x0 : 0.f;
            const float x2 = (lane < i0 + 2) ? acc[2] - d2.x * x0 - d2.y * x1 : 0.f;
            const float x3 = (lane < i0 + 3) ? acc[3] - d3.x * x0 - d3.y * x1 - d3.z * x2 : 0.f;
            DN_LFENCE();
            Rf[(i0 + 0) * 68 + lane] = x0; Rf[(i0 + 1) * 68 + lane] = x1; Rf[(i0 + 2) * 68 + lane] = x2; Rf[(i0 + 3) * 68 + lane] = x3;
            DN_LFENCE();
        } }
        bf16x8 T1[4][2], T2[4][2];
        { DNB_RELANE();
#pragma unroll
        for (int mt = 0; mt < 4; ++mt) { const int i = 16 * mt + fr;
#pragma unroll
            for (int k2 = 0; k2 < 2; ++k2) { const int j0 = 32 * k2 + 4 * fq;
                const float4 n0 = *(const float4*)(Rf + i * 68 + j0), n1 = *(const float4*)(Rf + i * 68 + j0 + 16);
                const float4 b0 = *(const float4*)(bts + j0), b1 = *(const float4*)(bts + j0 + 16), g0 = *(const float4*)(gcs + j0), g1 = *(const float4*)(gcs + j0 + 16);
                float tv[8] = {n0.x, n0.y, n0.z, n0.w, n1.x, n1.y, n1.z, n1.w}; const float bv[8] = {b0.x, b0.y, b0.z, b0.w, b1.x, b1.y, b1.z, b1.w}, gv[8] = {g0.x, g0.y, g0.z, g0.w, g1.x, g1.y, g1.z, g1.w};
                float t1[8], t2[8];
#pragma unroll
                for (int e = 0; e < 8; ++e) { const int j = j0 + 16 * (e >> 2) + (e & 3); if (j == i) tv[e] += 1.0f; t1[e] = tv[e] * bv[e]; t2[e] = -t1[e] * __expf(gv[e]); }
                T1[mt][k2] = pack8((f32x4){t1[0], t1[1], t1[2], t1[3]}, (f32x4){t1[4], t1[5], t1[6], t1[7]});
                T2[mt][k2] = pack8((f32x4){t2[0], t2[1], t2[2], t2[3]}, (f32x4){t2[4], t2[5], t2[6], t2[7]});
                __builtin_amdgcn_sched_barrier(0); } } }
        DN_LFENCE();
        { DNB_RELANE();
#pragma unroll
        for (int it = 0; it < 16; ++it) { const int j = it * 4 + (lane >> 4); *(u32x4*)(R + j * 256 + (lane & 15) * 16) = tile[it]; }
#pragma unroll
        for (int it = 0; it < 16; ++it) { const int j = it * 4 + (lane >> 4); tile[it] = *(const u32x4*)(QKV + (size_t)(row0 + (dir ? 63 - j : j)) * 3072 + hv + (lane & 15) * 8); }
        DN_LFENCE();
        const unsigned tra = rb + (4 * fq + ((lane & 15) >> 2)) * 256 + (lane & 3) * 8;
#pragma unroll
        for (int kk = 0; kk < 4; ++kk) { bf16x8 KT[2][2];
#pragma unroll
            for (int s2 = 0; s2 < 2; ++s2)
#pragma unroll
                for (int k2 = 0; k2 < 2; ++k2) { const int m8 = 2 * kk + s2; const unsigned a0 = tra + (32 * k2) * 256 + m8 * 32; KT[s2][k2] = tr_read2(a0, a0 + 16 * 256);
                    *(bf16x8*)(U + DNU_KT + ((m8 * 2 + k2) * 64 + lane) * 16) = KT[s2][k2]; }
#pragma unroll
            for (int mt = 0; mt < 4; ++mt) { f32x4 w0 = {0.f, 0.f, 0.f, 0.f}, w1 = {0.f, 0.f, 0.f, 0.f};
                w0 = __builtin_amdgcn_mfma_f32_16x16x32_bf16(KT[0][0], T2[mt][0], w0, 0, 0, 0); w0 = __builtin_amdgcn_mfma_f32_16x16x32_bf16(KT[0][1], T2[mt][1], w0, 0, 0, 0);
                w1 = __builtin_amdgcn_mfma_f32_16x16x32_bf16(KT[1][0], T2[mt][0], w1, 0, 0, 0); w1 = __builtin_amdgcn_mfma_f32_16x16x32_bf16(KT[1][1], T2[mt][1], w1, 0, 0, 0);
                *(bf16x8*)(U + DNU_W + ((mt * 4 + kk) * 64 + lane) * 16) = pack8(w0, w1); } }
        DN_LFENCE();
#pragma unroll
        for (int it = 0; it < 16; ++it) { const int j = it * 4 + (lane >> 4); *(u32x4*)(R + j * 256 + (lane & 15) * 16) = tile[it]; }
        DN_LFENCE();
#pragma unroll
        for (int n8 = 0; n8 < 8; ++n8) { const unsigned a0 = tra + n8 * 32;
            const bf16x8 V0 = tr_read2(a0, a0 + 16 * 256), V1 = tr_read2(a0 + 32 * 256, a0 + 48 * 256);
#pragma unroll
            for (int mt = 0; mt < 4; ++mt) { f32x4 acc = {0.f, 0.f, 0.f, 0.f};
                acc = __builtin_amdgcn_mfma_f32_16x16x32_bf16(T1[mt][0], V0, acc, 0, 0, 0); acc = __builtin_amdgcn_mfma_f32_16x16x32_bf16(T1[mt][1], V1, acc, 0, 0, 0);
                uint2 w; w.x = cvtpk(acc[0], acc[1]); w.y = cvtpk(acc[2], acc[3]);
                *(uint2*)(U + DNU_U + ((n8 * 4 + mt) * 64 + lane) * 8) = w; } }
        DN_LFENCE(); }
    }
#undef DNB_RELANE
}

constexpr int DNS_BUF = 65792;
__device__ __forceinline__ void phase_dnscan(const Params& p, int l, unsigned char* lds, int wv) {
    using namespace dn;
    const int tid = opaque_tid(wv), wid = __builtin_amdgcn_readfirstlane(tid >> 6), lane0 = tid & 63;
    const unsigned char* DNP = p.ws + WS_DNP; bf16_t* DNO = wsb(p, WS_DNO);
    for (int u = blockIdx.x; u < 768; u += gridDim.x) {
        int b, NC, row0; const bool lat = u < 256;
        const int v = lat ? u : u - 256; b = v >> 5; const int h = (v >> 2) & 7, dir = (v >> 1) & 1, half = v & 1;
        if (lat) { NC = 64; row0 = M_CTX + b * 4096; } else { NC = 4; row0 = b * 256; }
        const int gch0 = row0 >> 6;
        const int dv0 = (half * 4 + wid) * 16;
        const int lt0 = tid - 256;
#define DNS_LOAD(S, G, n) do { const int _cn = dir ? NC - 1 - (n) : (n); const unsigned char* _rec = DNP + (size_t)(((gch0 + _cn) * 8 + h) * 2 + dir) * DN_UNIT; \
        _Pragma("unroll") for (int _i = 0; _i < 16; ++_i) { const int _q = lt + 256 * _i; \
            S[_i] = *(const u32x4*)(_rec + (_q < 3584 ? _q * 16 : DNU_U + half * 8192 + (_q - 3584) * 16)); } \
        if (lt < 16) G = *(const u32x4*)(_rec + DNU_GC + lt * 16); } while (0)
#define DNS_STORE(S, G, bufp) do { _Pragma("unroll") for (int _i = 0; _i < 16; ++_i) *(u32x4*)((bufp) + (lt + 256 * _i) * 16) = S[_i]; \
        if (lt < 16) *(u32x4*)((bufp) + 65536 + lt * 16) = G; } while (0)
        if (wid < 4) {
            f32x4 S[8]; bf16x8 SB[4];
            { int lane = lane0; asm volatile("" : "+v"(lane)); const int fr = lane & 15, fq = lane >> 4;
            if (lat) { const float* s0 = inp(IN_STATE_DN) + ((((size_t)b * 2 + l) * 2 + dir) * 8 + h) * 128 * 128;
#pragma unroll
                for (int m8 = 0; m8 < 8; ++m8)
#pragma unroll
                    for (int r = 0; r < 4; ++r) S[m8][r] = s0[(size_t)(16 * m8 + 4 * fq + r) * 128 + dv0 + fr]; }
            else {
#pragma unroll
                for (int m8 = 0; m8 < 8; ++m8) S[m8] = (f32x4){0.f, 0.f, 0.f, 0.f}; }
#pragma unroll
            for (int kk = 0; kk < 4; ++kk) SB[kk] = pack8(S[2 * kk], S[2 * kk + 1]);
        }
            __syncthreads();
            __syncthreads();
            for (int n = 0; n < NC; ++n) {
                unsigned char* buf = lds + (n & 1) * DNS_BUF;
                int lane = lane0; asm volatile("" : "+v"(lane)); const int fr = lane & 15, fq = lane >> 4;
                const int cn = dir ? NC - 1 - n : n; const int t0 = row0 + cn * 64;
                const float gl = *(const float*)(buf + 65536 + 63 * 4);
                f32x4 vn[4];
#pragma unroll
                for (int mt = 0; mt < 4; ++mt) { const uint2 uu = *(const uint2*)(buf + 57344 + ((wid * 4 + mt) * 64 + lane) * 8);
                    vn[mt] = (f32x4){__uint_as_float(uu.x << 16), __uint_as_float(uu.x & 0xffff0000u), __uint_as_float(uu.y << 16), __uint_as_float(uu.y & 0xffff0000u)};
#pragma unroll
                    for (int kk = 0; kk < 4; ++kk) vn[mt] = __builtin_amdgcn_mfma_f32_16x16x32_bf16(*(const bf16x8*)(buf + DNU_W + ((mt * 4 + kk) * 64 + lane) * 16), SB[kk], vn[mt], 0, 0, 0); }
                const bf16x8 VB0 = pack8(vn[0], vn[1]), VB1 = pack8(vn[2], vn[3]);
                f32x4 eh[4];
#pragma unroll
                for (int mt = 0; mt < 4; ++mt) { const float4 gi = *(const float4*)(buf + 65536 + (16 * mt + 4 * fq) * 4);
                    f32x4 oa = {0.f, 0.f, 0.f, 0.f};
#pragma unroll
                    for (int kk = 0; kk < 4; ++kk) oa = __builtin_amdgcn_mfma_f32_16x16x32_bf16(*(const bf16x8*)(buf + DNU_Q + ((mt * 4 + kk) * 64 + lane) * 16), SB[kk], oa, 0, 0, 0);
                    oa[0] *= ATT_SCALE * __expf(gi.x); oa[1] *= ATT_SCALE * __expf(gi.y); oa[2] *= ATT_SCALE * __expf(gi.z); oa[3] *= ATT_SCALE * __expf(gi.w);
                    eh[mt] = (f32x4){__expf(gl - gi.x), __expf(gl - gi.y), __expf(gl - gi.z), __expf(gl - gi.w)};
                    oa = __builtin_amdgcn_mfma_f32_16x16x32_bf16(*(const bf16x8*)(buf + DNU_QK + ((mt * 2 + 0) * 64 + lane) * 16), VB0, oa, 0, 0, 0);
                    oa = __builtin_amdgcn_mfma_f32_16x16x32_bf16(*(const bf16x8*)(buf + DNU_QK + ((mt * 2 + 1) * 64 + lane) * 16), VB1, oa, 0, 0, 0);
#pragma unroll
                    for (int r = 0; r < 4; ++r) { const int i = 16 * mt + 4 * fq + r;
                        DNO[((size_t)dir * M_ALL + t0 + (dir ? 63 - i : i)) * 1024 + h * 128 + dv0 + fr] = f2bf(oa[r]); } }
                const bf16x8 WB0 = pack8(vn[0] * eh[0], vn[1] * eh[1]), WB1 = pack8(vn[2] * eh[2], vn[3] * eh[3]);
                const float eg = __expf(gl);
#pragma unroll
                for (int m8 = 0; m8 < 8; ++m8) { S[m8] = S[m8] * eg;
                    S[m8] = __builtin_amdgcn_mfma_f32_16x16x32_bf16(*(const bf16x8*)(buf + DNU_KT + ((m8 * 2 + 0) * 64 + lane) * 16), WB0, S[m8], 0, 0, 0);
                    S[m8] = __builtin_amdgcn_mfma_f32_16x16x32_bf16(*(const bf16x8*)(buf + DNU_KT + ((m8 * 2 + 1) * 64 + lane) * 16), WB1, S[m8], 0, 0, 0); }
#pragma unroll
                for (int kk = 0; kk < 4; ++kk) SB[kk] = pack8(S[2 * kk], S[2 * kk + 1]);
                __syncthreads();
            }
            if (!lat) { int lane = lane0; asm volatile("" : "+v"(lane)); const int fr = lane & 15, fq = lane >> 4; float* so = p.out + OUT_ST + ((((size_t)b * 2 + l) * 2 + dir) * 8 + h) * 128 * 128;
#pragma unroll
            for (int m8 = 0; m8 < 8; ++m8)
#pragma unroll
                for (int r = 0; r < 4; ++r) so[(size_t)(16 * m8 + 4 * fq + r) * 128 + dv0 + fr] = S[m8][r]; }
        } else {
            u32x4 sa[16], sb[16], ga = {0u, 0u, 0u, 0u}, gb = {0u, 0u, 0u, 0u};
            __syncthreads();
            { int lt = lt0; asm volatile("" : "+v"(lt)); DNS_LOAD(sa, ga, 0); if (NC > 1) DNS_LOAD(sb, gb, 1); DNS_STORE(sa, ga, lds); }
            __syncthreads();
            for (int n = 0; n < NC; ++n) { unsigned char* nbuf = lds + ((n + 1) & 1) * DNS_BUF;
                int lt = lt0; asm volatile("" : "+v"(lt));
                if (n & 1) { if (n + 2 < NC) DNS_LOAD(sb, gb, n + 2); if (n + 1 < NC) DNS_STORE(sa, ga, nbuf); }
                else { if (n + 2 < NC) DNS_LOAD(sa, ga, n + 2); if (n + 1 < NC) DNS_STORE(sb, gb, nbuf); }
                __syncthreads();
            }
        }
#undef DNS_LOAD
#undef DNS_STORE
    }
}

enum { PH_MOD = 0, PH_CVT, PH_PRENORM, PH_GEMM1, PH_ATTNPREP, PH_DNPRE, PH_ATTN, PH_DNB, PH_DNSCAN, PH_DNCOMB, PH_GEMM2, PH_POSTNORM };

__global__ void __launch_bounds__(NTHR, 2) mega(Params p) {
    extern __shared__ __attribute__((aligned(16))) unsigned char lds[];
    const bool all = p.phase < 0;
    const int wv = __builtin_amdgcn_readfirstlane((int)(threadIdx.x >> 6));
    XcdBarrier bar;
    if (threadIdx.x == 0) {
        *(uint4*)(lds + LDS_CTL_OFF) = make_uint4(0u, 0u, 0u, 0u);
#pragma unroll
        for (int i = 0; i < IN_COUNT; ++i) *(unsigned long long*)(lds + LDS_TAB_OFF + i * 8) = (unsigned long long)p.in[i];
    }
    __syncthreads();
    if (all) {
        bar = xcd_barrier_post((unsigned*)(p.ws + WS_CTL), (volatile LAS unsigned*)(lds + LDS_CTL_OFF));
    }
#define SEAM() do { if (all) xcd_barrier(bar); } while (0)
#ifdef TEST_ONLY
#define RUN(id) ((id) == TEST_ONLY && (all || p.phase == (id)))
#else
#define RUN(id) (all || p.phase == (id))
#endif
    if (RUN(PH_MOD)) phase_mod(p, lds, wv);
    if (RUN(PH_CVT)) phase_cvt(p, lds, wv);
    SEAM();
    const int l0 = all ? 0 : p.layer, l1 = all ? 2 : p.layer + 1;
    for (int l = l0; l < l1; ++l) {
        if (l == 0) { if (RUN(PH_PRENORM)) phase_prenorm(p, l, wv); SEAM(); }
        if (RUN(PH_GEMM1)) phase_gemm1(p, l, lds, wv);
        SEAM();
        if (RUN(PH_ATTNPREP)) phase_attnprep(p, l, lds, wv);
        if (RUN(PH_DNPRE)) phase_dnpre(p, l, wv);
        SEAM();
        if (RUN(PH_ATTN)) phase_attn(p, l, lds, wv);
        SEAM();
        if (RUN(PH_DNB)) phase_dnb(p, l, lds, wv);
        SEAM();
        if (RUN(PH_DNSCAN)) phase_dnscan(p, l, lds, wv);
        SEAM();
        if (RUN(PH_DNCOMB)) phase_dncomb(p, l, wv);
        SEAM();
        if (RUN(PH_GEMM2)) phase_gemm2(p, l, lds, wv);
        SEAM();
        if (RUN(PH_POSTNORM)) { if (l == 0) phase_postnorm<true>(p, l, wv); else phase_postnorm<false>(p, l, wv); }
        SEAM();
    }
#undef SEAM
#undef RUN
}

#ifndef MK_FUSED
#define MK_FUSED 1
#endif

extern "C" void kernel_launch(void* const* d_in, const int* in_sizes, int n_in, void* d_out, int out_size, void* d_ws, size_t ws_size, hipStream_t stream) {
    static int grid = 0;
    if (grid == 0) {
        if (n_in != 23 || ws_size < WS_END) { fprintf(stderr, "kernel_launch: unexpected n_in %d / ws_size %zu (need %zu)\n", n_in, ws_size, WS_END); return; }
        int dev = 0, cus = 0, per_cu = 0;
        if (hipGetDevice(&dev) != hipSuccess || hipDeviceGetAttribute(&cus, hipDeviceAttributeMultiprocessorCount, dev) != hipSuccess) { fprintf(stderr, "kernel_launch: device query failed\n"); return; }
        if (hipFuncSetAttribute((const void*)mega, hipFuncAttributeMaxDynamicSharedMemorySize, LDS_BYTES) != hipSuccess) { fprintf(stderr, "kernel_launch: hipFuncSetAttribute failed\n"); return; }
        if (hipOccupancyMaxActiveBlocksPerMultiprocessor(&per_cu, (const void*)mega, NTHR, LDS_BYTES) != hipSuccess || per_cu < 1) { fprintf(stderr, "kernel_launch: occupancy query says %d\n", per_cu); return; }
        grid = cus;
    }
    Params p; memset(&p, 0, sizeof(p));
    for (int i = 0; i < IN_COUNT; ++i) p.in[i] = (const float*)d_in[i];
    p.out = (float*)d_out; p.ws = (unsigned char*)d_ws;
#if MK_FUSED
    hipMemsetAsync((char*)d_ws + WS_CTL, 0, CTL_BYTES, stream);
    p.phase = -1; p.layer = 0;
    hipLaunchKernelGGL(mega, dim3(grid), dim3(NTHR), LDS_BYTES, stream, p);
#else
    p.phase = PH_MOD; p.layer = 0; hipLaunchKernelGGL(mega, dim3(grid), dim3(NTHR), LDS_BYTES, stream, p);
    p.phase = PH_CVT; hipLaunchKernelGGL(mega, dim3(grid), dim3(NTHR), LDS_BYTES, stream, p);
    for (int l = 0; l < 2; ++l)
        for (int ph = PH_PRENORM; ph <= PH_POSTNORM; ++ph) { if ((l == 1 && ph == PH_PRENORM)) continue; p.phase = ph; p.layer = l; hipLaunchKernelGGL(mega, dim3(grid), dim3(NTHR), LDS_BYTES, stream, p); }
#endif
    const hipError_t le = hipPeekAtLastError();
    if (le != hipSuccess) fprintf(stderr, "kernel_launch: launch failed: %s\n", hipGetErrorName(le));
}
```
